# Optimizing an MI355X kernel written in HIP

```python
import math
import jax, jax.numpy as jnp
from jax import lax
import numpy as np

D_MODEL = 1024
BATCH = 4
SEQ = 8192
DEPTH = 1

HEAD_DIM = 64
N_HEADS_A = 8
N_KV_A = 2
N_HEADS_B = 8
WIDTH_A = N_HEADS_A * HEAD_DIM
WIDTH_B = N_HEADS_B * HEAD_DIM
MIX_WIDTH = WIDTH_A + WIDTH_B
KV_WIDTH_A = N_KV_A * HEAD_DIM
IN_WIDTH = WIDTH_A + 2 * KV_WIDTH_A + 3 * WIDTH_B
GRID_W = 64
WIN_R_MAX = 8
WIN_C = 16
Q_BLOCK = 128
ROPE_THETA = 10000.0
D_FF = -(-8 * D_MODEL // (3 * 256)) * 256
EPS = 1e-6

kernel_name = "hymba_gqa_axialrope_natten2d_swiglu"


def rmsnorm(x, g):
    xf = x.astype(jnp.float32)
    y = xf * lax.rsqrt(jnp.mean(xf * xf, axis=-1, keepdims=True) + EPS)
    return (y * g.astype(jnp.float32)).astype(x.dtype)


def axial_rope_tables(seq):
    t = jnp.arange(seq)
    row = (t // GRID_W).astype(jnp.float32)
    col = (t % GRID_W).astype(jnp.float32)
    half = HEAD_DIM // 2
    inv_freq = ROPE_THETA ** (-jnp.arange(0, half, 2, dtype=jnp.float32) / half)
    ang_r = row[:, None] * inv_freq[None, :]
    ang_c = col[:, None] * inv_freq[None, :]
    return jnp.cos(ang_r), jnp.sin(ang_r), jnp.cos(ang_c), jnp.sin(ang_c)


def rope_half(x, cos, sin):
    x1, x2 = jnp.split(x, 2, axis=-1)
    c = cos[None, :, None, :]
    s = sin[None, :, None, :]
    return jnp.concatenate([x1 * c - x2 * s, x2 * c + x1 * s], axis=-1)


def apply_axial_rope(x, tabs):
    cr, sr, cc, sc = tabs
    xf = x.astype(jnp.float32)
    half = HEAD_DIM // 2
    out = jnp.concatenate([rope_half(xf[..., :half], cr, sr), rope_half(xf[..., half:], cc, sc)], axis=-1)
    return out.astype(x.dtype)


def gqa_axial_attention(q, k, v, q_gain, k_gain):
    b, s, _ = q.shape
    g = N_HEADS_A // N_KV_A
    q = rmsnorm(q.reshape(b, s, N_HEADS_A, HEAD_DIM), q_gain)
    k = rmsnorm(k.reshape(b, s, N_KV_A, HEAD_DIM), k_gain)
    v = v.reshape(b, s, N_KV_A, HEAD_DIM)
    tabs = axial_rope_tables(s)
    q = apply_axial_rope(q, tabs) * (1.0 / math.sqrt(HEAD_DIM))
    k = apply_axial_rope(k, tabs)
    nb = s // Q_BLOCK
    qb = q.reshape(b, nb, Q_BLOCK, N_KV_A, g, HEAD_DIM).transpose(1, 0, 2, 3, 4, 5)

    def block(qblk):
        sc = jnp.einsum('bqkgd,bskd->bkgqs', qblk, k)
        p = jax.nn.softmax(sc.astype(jnp.float32), axis=-1).astype(v.dtype)
        return jnp.einsum('bkgqs,bskd->bqkgd', p, v)

    o = lax.map(block, qb)
    return o.transpose(1, 0, 2, 3, 4, 5).reshape(b, s, WIDTH_A)


def neighbourhood_attention_2d(q, k, v, rpb):
    b, s, _ = q.shape
    rows = s // GRID_W
    wr = min(WIN_R_MAX, rows)
    nk = wr * WIN_C
    q = q.reshape(b, s, N_HEADS_B, HEAD_DIM) * (1.0 / math.sqrt(HEAD_DIM))
    k = k.reshape(b, s, N_HEADS_B, HEAD_DIM)
    v = v.reshape(b, s, N_HEADS_B, HEAD_DIM)
    t = jnp.arange(s)
    r = t // GRID_W
    c = t % GRID_W
    rs = jnp.clip(r - wr // 2, 0, rows - wr)
    cs = jnp.clip(c - WIN_C // 2, 0, GRID_W - WIN_C)
    kr = rs[:, None, None] + jnp.arange(wr)[None, :, None]
    kc = cs[:, None, None] + jnp.arange(WIN_C)[None, None, :]
    idx = (kr * GRID_W + kc).reshape(s, nk)
    dr = kr - r[:, None, None] + (WIN_R_MAX - 1)
    dc = kc - c[:, None, None] + (WIN_C - 1)
    bidx = (dr * (2 * WIN_C - 1) + dc).reshape(s, nk)
    rpb_flat = rpb.reshape(N_HEADS_B, -1)
    nb = s // Q_BLOCK
    qb = q.reshape(b, nb, Q_BLOCK, N_HEADS_B, HEAD_DIM).transpose(1, 0, 2, 3, 4)
    idx_b = idx.reshape(nb, Q_BLOCK, nk)
    bidx_b = bidx.reshape(nb, Q_BLOCK, nk)

    def block(args):
        qblk, ib, bb = args
        kg = jnp.take(k, ib, axis=1)
        vg = jnp.take(v, ib, axis=1)
        sc = jnp.einsum('bqhd,bqnhd->bhqn', qblk, kg).astype(jnp.float32)
        sc = sc + rpb_flat[:, bb].astype(jnp.float32)[None]
        p = jax.nn.softmax(sc, axis=-1).astype(v.dtype)
        return jnp.einsum('bhqn,bqnhd->bqhd', p, vg)

    o = lax.map(block, (qb, idx_b, bidx_b))
    return o.transpose(1, 0, 2, 3, 4).reshape(b, s, WIDTH_B)


def setup_inputs(seed: int = 0) -> dict:
    key = jax.random.key(seed)
    ks = jax.random.split(key, 16)
    f32 = jnp.float32

    def w(k, shape, fan_in):
        return jax.random.normal(k, shape, f32) * fan_in ** -0.5

    def gain(k, shape):
        return 1.0 + 0.01 * jax.random.normal(k, shape, f32)

    return {
        "x": jax.random.normal(ks[0], (BATCH, SEQ, D_MODEL), f32),
        "norm_mix": gain(ks[1], (DEPTH, D_MODEL)),
        "w_in": w(ks[2], (DEPTH, D_MODEL, IN_WIDTH), D_MODEL),
        "q_norm_a": gain(ks[3], (DEPTH, HEAD_DIM)),
        "k_norm_a": gain(ks[4], (DEPTH, HEAD_DIM)),
        "rpb_b": 0.1 * jax.random.normal(ks[5], (DEPTH, N_HEADS_B, 2 * WIN_R_MAX - 1, 2 * WIN_C - 1), f32),
        "out_norm_a": gain(ks[6], (DEPTH, WIDTH_A)),
        "out_norm_b": gain(ks[7], (DEPTH, WIDTH_B)),
        "w_out": w(ks[8], (DEPTH, MIX_WIDTH, D_MODEL), MIX_WIDTH),
        "norm_ffn": gain(ks[9], (DEPTH, D_MODEL)),
        "w_gate": w(ks[10], (DEPTH, D_MODEL, D_FF), D_MODEL),
        "w_up": w(ks[11], (DEPTH, D_MODEL, D_FF), D_MODEL),
        "w_down": w(ks[12], (DEPTH, D_FF, D_MODEL), D_FF),
        "norm_final": gain(ks[13], (D_MODEL,)),
    }


def reference(x, norm_mix, w_in, q_norm_a, k_norm_a, rpb_b, out_norm_a, out_norm_b,
              w_out, norm_ffn, w_gate, w_up, w_down, norm_final):
    splits = [WIDTH_A, WIDTH_A + KV_WIDTH_A, WIDTH_A + 2 * KV_WIDTH_A,
              WIDTH_A + 2 * KV_WIDTH_A + WIDTH_B, WIDTH_A + 2 * KV_WIDTH_A + 2 * WIDTH_B]
    for l in range(DEPTH):
        h = rmsnorm(x, norm_mix[l])
        proj = jnp.einsum('bsd,de->bse', h, w_in[l])
        q_a, k_a, v_a, q_b, k_b, v_b = jnp.split(proj, splits, axis=-1)
        o_a = gqa_axial_attention(q_a, k_a, v_a, q_norm_a[l], k_norm_a[l])
        o_b = neighbourhood_attention_2d(q_b, k_b, v_b, rpb_b[l])
        mixed = jnp.concatenate([rmsnorm(o_a, out_norm_a[l]), rmsnorm(o_b, out_norm_b[l])], axis=-1)
        x = x + jnp.einsum('bse,ed->bsd', mixed, w_out[l])
        h = rmsnorm(x, norm_ffn[l])
        gate = jnp.einsum('bsd,df->bsf', h, w_gate[l])
        up = jnp.einsum('bsd,df->bsf', h, w_up[l])
        x = x + jnp.einsum('bsf,fd->bsd', jax.nn.silu(gate) * up, w_down[l])
    return rmsnorm(x, norm_final)
```

```cpp
#include <hip/hip_runtime.h>
#include <hip/hip_cooperative_groups.h>
#include <cstdio>
#include <cstdint>
namespace cg = cooperative_groups;

#define LAS __attribute__((address_space(3)))
#define DI __device__ __forceinline__
typedef unsigned short bf16_t;
typedef short bf16x8 __attribute__((ext_vector_type(8)));
typedef float f32x4 __attribute__((ext_vector_type(4)));
typedef float f32x2 __attribute__((ext_vector_type(2)));
typedef float f32x16 __attribute__((ext_vector_type(16)));
typedef unsigned u32x4 __attribute__((ext_vector_type(4)));
typedef unsigned u32x2 __attribute__((ext_vector_type(2)));

constexpr int NTOK = 32768, DM = 1024, SEQL = 8192, INW = 2304, DFF = 2816;
constexpr float EPS = 1e-6f;
constexpr float LOG2E = 1.4426950408889634f;
constexpr float QSCALE = 0.125f * LOG2E;

constexpr size_t OFF_WT_IN = 0;
constexpr size_t OFF_WT_OUT = OFF_WT_IN + (size_t)INW * DM * 2;
constexpr size_t OFF_WT_GU = OFF_WT_OUT + (size_t)DM * DM * 2;
constexpr size_t OFF_WT_DN = OFF_WT_GU + (size_t)2 * DFF * DM * 2;
constexpr size_t OFF_ROPE = OFF_WT_DN + (size_t)DM * DFF * 2;
constexpr size_t OFF_SSO = OFF_ROPE + 128 * 16 * 8;
constexpr size_t OFF_SS2 = OFF_SSO + (size_t)NTOK * 16 * 4;
constexpr size_t OFF_SS3 = OFF_SS2 + (size_t)NTOK * 16 * 4;
constexpr size_t OFF_OMIX = OFF_SS3 + (size_t)NTOK * 16 * 4;
constexpr size_t OFF_X1B = OFF_OMIX + (size_t)NTOK * DM * 2;
constexpr size_t OFF_XN = OFF_X1B + (size_t)NTOK * DM * 2;
constexpr size_t OFF_QA = OFF_XN + (size_t)NTOK * DM * 2;
constexpr size_t OFF_KA = OFF_QA + (size_t)NTOK * 512 * 2;
constexpr size_t OFF_VTA = OFF_KA + (size_t)NTOK * 128 * 2;
constexpr size_t OFF_QB = OFF_VTA + (size_t)NTOK * 128 * 2;
constexpr size_t OFF_KB = OFF_QB + (size_t)NTOK * 512 * 2;
constexpr size_t OFF_VTB = OFF_KB + (size_t)NTOK * 512 * 2;
constexpr size_t OFF_BAR = OFF_VTB + (size_t)NTOK * 512 * 2;
constexpr size_t OFF_PCNT = OFF_BAR + 16384;
constexpr size_t OFF_XBUF = OFF_PCNT + 128 * 256;
constexpr size_t OFF_MREF = OFF_XBUF + (size_t)NTOK * 4 * 4;
constexpr size_t OFF_H = OFF_XN;
static_assert(OFF_VTB + (size_t)NTOK * 512 * 2 - OFF_XN >= (size_t)NTOK * DFF * 2, "h overlay does not fit");

struct Params {
    const float *x, *norm_mix, *w_in, *q_norm_a, *k_norm_a, *rpb, *out_norm_a, *out_norm_b, *w_out, *norm_ffn, *w_gate, *w_up, *w_down, *norm_final;
    float* out;
    unsigned char* ws;
};

typedef __bf16 bf16x2_t __attribute__((ext_vector_type(2)));
DI unsigned pack2(float lo, float hi) { const f32x2 v = {lo, hi}; return __builtin_bit_cast(unsigned, __builtin_convertvector(v, bf16x2_t)); }
#define WAIT_V(n) asm volatile("s_waitcnt vmcnt(" #n ")" ::: "memory")
#define BAR __builtin_amdgcn_s_barrier()

constexpr int BM = 256, BK = 64, HALF = 128, HTB = HALF * BK * 2, STAGE_BYTES = 8 * HTB, NXCD = 8, WGM = 8;
constexpr int TAB_OFF = STAGE_BYTES;
DI int lds_byte(int r, int c) { const int st = (r >> 4) * 2 + (c >> 5), rr = r & 15, cc = c & 31, ob = rr * 64 + cc * 2; return st * 1024 + (ob ^ (((ob >> 9) & 1) << 5)); }
DI void stage_rc(int b, int& R, int& C) { const int st = b / 1024, sb = b % 1024, swz = sb ^ (((sb >> 9) & 1) << 5); R = (st >> 1) * 16 + swz / 64; C = (st & 1) * 32 + (swz % 64) / 2; }
struct Unit { int pm, pn, hn; };
struct Gemm { const bf16_t* A; const bf16_t* Bt; int K; };
struct StaticOrder {
    int nM, nN, nwg, G, c;
    DI void init(int M, int N, int G_, int c_) { nM = M / BM; nN = N / BM; nwg = nM * nN; G = G_; c = c_; }
    DI bool next(int i, Unit& u) const {
        const long L = (long)i * G + c; if (L >= nwg) return false;
        int wgid = (int)L; { const int q = nwg / NXCD, r = nwg % NXCD, xcd = wgid % NXCD, off = wgid / NXCD; wgid = (xcd < r ? xcd * (q + 1) : r * (q + 1) + (xcd - r) * q) + off; }
        const int nig = WGM * nN, gid = wgid / nig, fm = gid * WGM, gsz = (nM - fm) < WGM ? (nM - fm) : WGM;
        u.pm = fm + ((wgid % nig) % gsz); u.pn = (wgid % nig) / gsz; u.hn = 0; return true;
    }
};
struct QkvOrder {
    StaticOrder S8; int G, c;
    DI void init(int G_, int c_) { S8.init(NTOK, 8 * BM, G_, c_); G = G_; c = c_; }
    DI bool next(int i, Unit& u) const {
        const long L = (long)i * G + c;
        if (L < 1024) return S8.next(i, u);
        const int h = (int)L - 1024; if (h >= 256) return false;
        u.pm = h >> 1; u.pn = 8; u.hn = 1 + (h & 1); return true;
    }
};
typedef LAS f32x2* tab_t;

template <class Epi, class Sched>
DI void gemm_phase(LAS unsigned char* lds, const Gemm g, const Sched& S, const Epi& E) {
    const int tid = threadIdx.x, wid = __builtin_amdgcn_readfirstlane(tid >> 6), lane = tid & 63, wr = wid >> 2, wc = wid & 3, fr = lane & 15, fq = lane >> 4;
    const int K = g.K, nt = K / BK;
    unsigned voffA[2];
#pragma unroll
    for (int i = 0; i < 2; ++i) { int R, C; stage_rc(tid * 16 + i * 8192, R, C); voffA[i] = (unsigned)(R * K + C) * 2u; }
    const size_t kstep = (size_t)(BK * 2), hstep = (size_t)HALF * K * 2, tstep = 2 * hstep;
    const unsigned ldsw = (unsigned)wid * 1024u;
    const int aoff = lds_byte(wr * 64 + fr, fq * 8), boff = lds_byte(wc * 32 + fr, fq * 8);
#define G_SA(b, h) (((b) * 2 + (h)) * HTB)
#define G_SB(b, h) ((4 + (b) * 2 + (h)) * HTB)
#define G_STAGE(bufoff, gbase) do { _Pragma("unroll") for (int _i = 0; _i < 2; ++_i) \
        __builtin_amdgcn_global_load_lds((const unsigned*)((const char*)(gbase) + voffA[_i]), (LAS unsigned*)(lds + (bufoff) + ldsw + _i * 8192), 16, 0, 0); } while (0)
#define G_LDA(dst, b, h) do { _Pragma("unroll") for (int m = 0; m < 4; ++m) _Pragma("unroll") for (int k = 0; k < 2; ++k) dst[m][k] = *(const LAS bf16x8*)(lds + G_SA(b, h) + aoff + m * 2048 + k * 1024); } while (0)
#define G_LDB(dst, b, h) do { _Pragma("unroll") for (int n = 0; n < 2; ++n) _Pragma("unroll") for (int k = 0; k < 2; ++k) dst[n][k] = *(const LAS bf16x8*)(lds + G_SB(b, h) + boff + n * 2048 + k * 1024); } while (0)
#define G_MMA(ai, bj, At, Bt) do { __builtin_amdgcn_s_setprio(1); _Pragma("unroll") for (int m = 0; m < 4; ++m) _Pragma("unroll") for (int n = 0; n < 2; ++n) _Pragma("unroll") for (int k = 0; k < 2; ++k) \
        acc[ai][bj][m][n] = __builtin_amdgcn_mfma_f32_16x16x32_bf16(Bt[n][k], At[m][k], acc[ai][bj][m][n], 0, 0, 0); __builtin_amdgcn_s_setprio(0); } while (0)
#define G_WAIT_L(n) asm volatile("s_waitcnt lgkmcnt(" #n ")" ::: "memory")
#define G_SCHED __builtin_amdgcn_sched_barrier(0)
    Unit cur, nxt; int ui = 0;
    if (!S.next(0, cur)) return;
    f32x4 acc[2][2][4][2];
#pragma unroll
    for (int a = 0; a < 2; ++a)
#pragma unroll
        for (int b = 0; b < 2; ++b)
#pragma unroll
            for (int m = 0; m < 4; ++m)
#pragma unroll
                for (int n = 0; n < 2; ++n) acc[a][b][m][n] = (f32x4){0.f, 0.f, 0.f, 0.f};
    bf16x8 At[4][2], B0[2][2], B1[2][2];
    const char* cA = (const char*)g.A + (size_t)cur.pm * tstep; const char* cB = (const char*)g.Bt + (size_t)cur.pn * tstep + (cur.hn == 2 ? hstep : 0);
    if (Epi::HAS_PREP) { E.prep(cur, (tab_t)(lds + TAB_OFF)); WAIT_V(0); }
    G_STAGE(G_SB(0, 0), cB); G_STAGE(G_SB(0, 1), cB + hstep); G_STAGE(G_SA(0, 0), cA); G_STAGE(G_SA(0, 1), cA + hstep);
    if (wr == 1) BAR;
    WAIT_V(2); BAR;
    G_STAGE(G_SB(1, 0), cB + kstep); G_STAGE(G_SA(1, 0), cA + kstep); G_STAGE(G_SB(1, 1), cB + hstep + kstep);
    WAIT_V(6); BAR;
    for (;;) {
        const bool has_next = S.next(ui + 1, nxt);
        const char* nA = has_next ? (const char*)g.A + (size_t)nxt.pm * tstep : cA; const char* nB = has_next ? (const char*)g.Bt + (size_t)nxt.pn * tstep + (nxt.hn == 2 ? hstep : 0) : cB;
        tab_t tab = (tab_t)(lds + TAB_OFF + (ui & 1) * 2048);
        const bool fullw = cur.hn == 0;
        for (int t = 0; t < nt; t += 2) {
            const bool last = (t == nt - 2);
            const char* a1 = cA + (size_t)(t + 1) * kstep;
            const char* a2 = last ? nA : cA + (size_t)(t + 2) * kstep; const char* b2 = last ? nB : cB + (size_t)(t + 2) * kstep;
            const char* a3 = a2 + kstep; const char* b3 = b2 + kstep;
            if (Epi::HAS_MID) { if (t == Epi::MID_T) E.mid(acc, tab, wr, fr); }
            G_LDB(B0, 0, 0); G_LDB(B1, 0, 1); G_SCHED; G_LDA(At, 0, 0); G_STAGE(G_SA(1, 1), a1 + hstep);
            WAIT_V(8); G_WAIT_L(0); BAR; G_MMA(0, 0, At, B0); if (fullw) G_MMA(0, 1, At, B1); BAR; G_SCHED;
            G_LDA(At, 0, 1); G_STAGE(G_SB(0, 0), b2); G_STAGE(G_SB(0, 1), b2 + hstep); G_STAGE(G_SA(0, 0), a2);
            WAIT_V(8); G_WAIT_L(0); BAR; G_MMA(1, 0, At, B0); if (fullw) G_MMA(1, 1, At, B1); BAR; G_SCHED;
            G_LDB(B0, 1, 0); G_LDB(B1, 1, 1); G_SCHED; G_LDA(At, 1, 0); G_STAGE(G_SA(0, 1), a2 + hstep);
            WAIT_V(8); G_WAIT_L(0); BAR; G_MMA(0, 0, At, B0); if (fullw) G_MMA(0, 1, At, B1); BAR; G_SCHED;
            G_LDA(At, 1, 1); G_STAGE(G_SB(1, 0), b3); G_STAGE(G_SB(1, 1), b3 + hstep); G_STAGE(G_SA(1, 0), a3);
            WAIT_V(8); G_WAIT_L(0); BAR; G_MMA(1, 0, At, B0); if (fullw) G_MMA(1, 1, At, B1); BAR; G_SCHED;
        }
        if (wr == 0) BAR;
        E(acc, cur, tab, wr, wc, fr, fq, lds);
        if (!has_next) break;
#pragma unroll
        for (int a = 0; a < 2; ++a)
#pragma unroll
            for (int b = 0; b < 2; ++b)
#pragma unroll
                for (int m = 0; m < 4; ++m)
#pragma unroll
                    for (int n = 0; n < 2; ++n) acc[a][b][m][n] = (f32x4){0.f, 0.f, 0.f, 0.f};
        cur = nxt; cA = nA; cB = nB; ++ui;
        if (Epi::HAS_PREP) E.prep(cur, (tab_t)(lds + TAB_OFF + (ui & 1) * 2048));
        if (wr == 1) BAR;
    }
    WAIT_V(0);
    BAR;
#undef G_SA
#undef G_SB
#undef G_STAGE
#undef G_LDA
#undef G_LDB
#undef G_MMA
#undef G_WAIT_L
#undef G_SCHED
}

DI void store4(bf16_t* dst, f32x4 v) { u32x2 w; w.x = pack2(v[0], v[1]); w.y = pack2(v[2], v[3]); *(u32x2*)dst = w; }
DI void store8(bf16_t* dst, f32x4 a, f32x4 b) { u32x4 w; w.x = pack2(a[0], a[1]); w.y = pack2(a[2], a[3]); w.z = pack2(b[0], b[1]); w.w = pack2(b[2], b[3]); *(u32x4*)dst = w; }
DI void store1(bf16_t* dst, float v) { *dst = (bf16_t)(pack2(v, v) & 0xffffu); }
DI float sum4(f32x4 a) { return (a[0] + a[1]) + (a[2] + a[3]); }
DI float sq4(f32x4 a) { return (a[0] * a[0] + a[1] * a[1]) + (a[2] * a[2] + a[3] * a[3]); }

DI int perm_slot(int f) { const int q = f & 31; return (f & ~31) | (((q >> 2) & 1) << 4) | ((q >> 3) << 2) | (q & 3); }
DI int map_row(int f, int rowmap) {
    if (rowmap == 0) return perm_slot(f);
    if (rowmap == 1) return (f >> 7) * 256 + perm_slot(f & 127);
    if (rowmap == 2) return (f >> 7) * 256 + 128 + perm_slot(f & 127);
    if (f >= 1792) return f;
    if (f >= 768) return perm_slot(f);
    const int pn = f >> 8, w = f & 255;
    return pn * 256 + ((w >> 5) & 1) * 128 + (w >> 6) * 32 + (w & 31);
}
DI void transpose_tile(const float* __restrict__ src, int N, int k0, int n0, const float* __restrict__ gA, const float* __restrict__ gB, int gsplit,
                       bf16_t* __restrict__ dst, int ldd, int rowmap, LAS unsigned char* lds) {
    const int tid = threadIdx.x, n = tid & 63, kq = tid >> 6;
    LAS unsigned* t32 = (LAS unsigned*)lds;
#pragma unroll
    for (int i = 0; i < 4; ++i) {
        const int k = kq * 8 + 2 * i, kg = k0 + k;
        float g0 = 1.f, g1 = 1.f;
        if (gA) { g0 = kg < gsplit ? gA[kg] : gB[kg - gsplit]; g1 = (kg + 1) < gsplit ? gA[kg + 1] : gB[kg + 1 - gsplit]; }
        const float v0 = src[(size_t)kg * N + n0 + n] * g0, v1 = src[(size_t)(kg + 1) * N + n0 + n] * g1;
        t32[n * 36 + (k >> 1)] = pack2(v0, v1);
    }
    __syncthreads();
    {
        const int nn = tid >> 3, ch = tid & 7;
        const u32x4 v = *(const LAS u32x4*)(lds + nn * 144 + ch * 16);
        *(u32x4*)(dst + (size_t)map_row(n0 + nn, rowmap) * ldd + k0 + ch * 8) = v;
    }
    __syncthreads();
}

DI float wave_sum(float v) {
#pragma unroll
    for (int o = 32; o >= 1; o >>= 1) v += __shfl_xor(v, o);
    return v;
}

DI void phase0(const Params& p, LAS unsigned char* lds) {
    bf16_t* wt_in = (bf16_t*)(p.ws + OFF_WT_IN);
    bf16_t* wt_out = (bf16_t*)(p.ws + OFF_WT_OUT);
    bf16_t* wt_gu = (bf16_t*)(p.ws + OFF_WT_GU);
    bf16_t* wt_dn = (bf16_t*)(p.ws + OFF_WT_DN);
    for (int j = blockIdx.x; j < 2944; j += gridDim.x) {
        if (j < 576) { const int kt = j / 36, nt = j % 36; transpose_tile(p.w_in, INW, kt * 64, nt * 64, p.norm_mix, p.norm_mix, DM, wt_in, DM, 3, lds); }
        else if (j < 832) { const int jj = j - 576, kt = jj / 16, nt = jj % 16; transpose_tile(p.w_out, DM, kt * 64, nt * 64, p.out_norm_a, p.out_norm_b, 512, wt_out, DM, 0, lds); }
        else if (j < 1536) { const int jj = j - 832, kt = jj / 44, nt = jj % 44; transpose_tile(p.w_gate, DFF, kt * 64, nt * 64, p.norm_ffn, p.norm_ffn, DM, wt_gu, DM, 1, lds); }
        else if (j < 2240) { const int jj = j - 1536, kt = jj / 44, nt = jj % 44; transpose_tile(p.w_up, DFF, kt * 64, nt * 64, p.norm_ffn, p.norm_ffn, DM, wt_gu, DM, 2, lds); }
        else { const int jj = j - 2240, kt = jj / 16, nt = jj % 16; transpose_tile(p.w_down, DM, kt * 64, nt * 64, nullptr, nullptr, 0, wt_dn, DFF, 0, lds); }
    }
    bf16_t* xn = (bf16_t*)(p.ws + OFF_XN);
    const int lane = threadIdx.x & 63, w = threadIdx.x >> 6;
    for (int row = blockIdx.x * 8 + w; row < NTOK; row += gridDim.x * 8) {
        const f32x4* xr = (const f32x4*)(p.x + (size_t)row * DM);
        f32x4 v[4]; float ss = 0.f;
#pragma unroll
        for (int i = 0; i < 4; ++i) { v[i] = __builtin_nontemporal_load(xr + lane + 64 * i); ss += sq4(v[i]); }
        ss = wave_sum(ss);
        const float rs = rsqrtf(ss * (1.0f / DM) + EPS);
#pragma unroll
        for (int i = 0; i < 4; ++i) store4(xn + (size_t)row * DM + (lane + 64 * i) * 4, v[i] * rs);
    }
    if (blockIdx.x == 0 && threadIdx.x < 64) {
        float gq = fabsf(p.q_norm_a[threadIdx.x]), gk = fabsf(p.k_norm_a[threadIdx.x]);
#pragma unroll
        for (int o = 32; o >= 1; o >>= 1) { gq = fmaxf(gq, __shfl_xor(gq, o)); gk = fmaxf(gk, __shfl_xor(gk, o)); }
        if (threadIdx.x == 0) *(float*)(p.ws + OFF_MREF) = 8.0f * LOG2E * gq * gk * 1.02f + 0.1f;
    }
    const int gt = blockIdx.x * 512 + threadIdx.x;
    if (gt < 2048) {
        const int pos = gt >> 4, i = gt & 15;
        const float invf = __builtin_amdgcn_exp2f(-(float)i * 0.830482023721841f);
        const float ang = (float)pos * invf;
        double rev = (double)ang * 0.15915494309189535;
        rev -= __builtin_rint(rev);
        const float rv = (float)rev;
        f32x2 cs; cs.x = __builtin_amdgcn_cosf(rv); cs.y = __builtin_amdgcn_sinf(rv);
        ((f32x2*)(p.ws + OFF_ROPE))[gt] = cs;
    }
}

struct EpiQKV {
    static constexpr bool HAS_PREP = false, HAS_MID = false; static constexpr int MID_T = -1;
    const float *qg, *kg; unsigned char* ws;
    DI void prep(const Unit&, tab_t) const {}
    DI void mid(f32x4 (&)[2][2][4][2], tab_t, int, int) const {}
    DI void rope_heads(const f32x4 (&acc)[2][2][4][2], const float* __restrict__ gain, float scale, bf16_t* __restrict__ dst, int ldd, int row0, int fr, int fq) const {
        const f32x4* rope = (const f32x4*)(ws + OFF_ROPE);
        f32x4 g[2][2];
#pragma unroll
        for (int bj = 0; bj < 2; ++bj)
#pragma unroll
            for (int n = 0; n < 2; ++n) g[bj][n] = *(const f32x4*)(gain + 32 * bj + 16 * n + 4 * fq);
#pragma unroll
        for (int ai = 0; ai < 2; ++ai)
#pragma unroll
            for (int m = 0; m < 4; ++m) {
                const int t = row0 + ai * HALF + m * 16 + fr;
                float ss = (sq4(acc[ai][0][m][0]) + sq4(acc[ai][0][m][1])) + (sq4(acc[ai][1][m][0]) + sq4(acc[ai][1][m][1]));
                ss += __shfl_xor(ss, 16); ss += __shfl_xor(ss, 32);
                const float rs = rsqrtf(ss * (1.0f / 64.0f) + EPS);
                const int sidx = t & (SEQL - 1), row = sidx >> 6, col = sidx & 63;
                bf16_t* d = dst + (size_t)t * ldd + fq * 4;
#pragma unroll
                for (int bj = 0; bj < 2; ++bj) {
                    const int pos = bj == 0 ? row : col;
                    const f32x4 t0 = rope[(pos * 16 + fq * 4) >> 1], t1 = rope[((pos * 16 + fq * 4) >> 1) + 1];
                    const float c[4] = {t0[0], t0[2], t1[0], t1[2]}, sn[4] = {t0[1], t0[3], t1[1], t1[3]};
                    f32x4 o0, o1;
#pragma unroll
                    for (int j = 0; j < 4; ++j) {
                        const float x1 = acc[ai][bj][m][0][j] * rs * g[bj][0][j], x2 = acc[ai][bj][m][1][j] * rs * g[bj][1][j];
                        o0[j] = (x1 * c[j] - x2 * sn[j]) * scale; o1[j] = (x2 * c[j] + x1 * sn[j]) * scale;
                    }
                    store4(d + 32 * bj, o0); store4(d + 32 * bj + 16, o1);
                }
            }
    }
    DI void vt_heads(const f32x4 (&acc)[2][2][4][2], bf16_t* __restrict__ base, int dsel  , int row0, int wc, int fr, int fq, int hn = 0) const {
#pragma unroll
        for (int ai = 0; ai < 2; ++ai)
#pragma unroll
            for (int m = 0; m < 4; ++m) {
                const int t = row0 + ai * HALF + m * 16 + fr, b = t >> 13, sidx = t & (SEQL - 1);
#pragma unroll
                for (int bjr = 0; bjr < 2; ++bjr) {
                    if (hn != 0 && bjr == 1) continue;
                    const int bj = hn ? hn - 1 : bjr;
#pragma unroll
                    for (int n = 0; n < 2; ++n) {
                        bf16_t* dp = dsel == 0 ? base + ((size_t)(b * 2) * 64 + 32 * bj + 16 * n + 4 * fq) * SEQL + sidx
                                               : base + ((size_t)(b * 8 + 2 * bj + (wc >> 1)) * 64 + (wc & 1) * 32 + 16 * n + 4 * fq) * SEQL + sidx;
#pragma unroll
                        for (int j = 0; j < 4; ++j) store1(dp + (size_t)j * SEQL, acc[ai][bjr][m][n][j]);
                    }
                }
            }
    }
    DI void operator()(f32x4 (&acc)[2][2][4][2], const Unit& u, tab_t, int wr, int wc, int fr, int fq, LAS unsigned char*) const {
        const int pn = u.pn, row0 = u.pm * BM + wr * 64;
        if (pn <= 1) {
            rope_heads(acc, qg, QSCALE, (bf16_t*)(ws + OFF_QA) + (pn * 4 + wc) * 64, 512, row0, fr, fq);
        } else if (pn == 2) {
            if (wc < 2) rope_heads(acc, kg, 1.0f, (bf16_t*)(ws + OFF_KA) + wc * 64, 128, row0, fr, fq);
            else vt_heads(acc, (bf16_t*)(ws + OFF_VTA) + (size_t)(wc - 2) * 64 * SEQL, 0, row0, wc, fr, fq);
        } else if (pn <= 6) {
            const bool isq = pn <= 4;
            bf16_t* base = isq ? (bf16_t*)(ws + OFF_QB) + (pn - 3) * 256 : (bf16_t*)(ws + OFF_KB) + (pn - 5) * 256;
            const float sc = isq ? QSCALE : 1.0f;
#pragma unroll
            for (int ai = 0; ai < 2; ++ai)
#pragma unroll
                for (int m = 0; m < 4; ++m) {
                    bf16_t* d = base + (size_t)(row0 + ai * HALF + m * 16 + fr) * 512 + wc * 32 + fq * 8;
#pragma unroll
                    for (int bj = 0; bj < 2; ++bj) store8(d + bj * HALF, acc[ai][bj][m][0] * sc, acc[ai][bj][m][1] * sc);
                }
        } else {
            vt_heads(acc, (bf16_t*)(ws + OFF_VTB) + (size_t)(pn - 7) * 4 * 64 * SEQL, 1, row0, wc, fr, fq, u.hn);
        }
    }
};

DI void phase1(const Params& p, LAS unsigned char* lds) {
    QkvOrder S; S.init(gridDim.x, blockIdx.x);
    Gemm g{(const bf16_t*)(p.ws + OFF_XN), (const bf16_t*)(p.ws + OFF_WT_IN), DM};
    EpiQKV E{p.q_norm_a, p.k_norm_a, p.ws};
    gemm_phase<EpiQKV, QkvOrder>(lds, g, S, E);
}

constexpr int AT_NS = 8, AT_D = AT_NS - 1, AT_STG = 16384, AT_RPB = AT_NS * AT_STG;
DI float max3(float a, float b, float c) { return __builtin_fmaxf(__builtin_fmaxf(a, b), c); }
template <bool NAT, bool STATIC>
DI void attn_unit(const Params& p, int unit, LAS unsigned char* lds) {
    const int tid = threadIdx.x, lane = tid & 63, w = __builtin_amdgcn_readfirstlane(tid >> 6), r = lane & 31, h = lane >> 5;
    const int b = unit >> 8, rem = unit & 255;
    int head, t0, ldk, key0, ntiles, ocol, hslot;
    const bf16_t *Qp, *Kp, *Vtp;
    int rw = 0, rsw = 0, krow0 = 0;
    if (!NAT) {
        const int xcd = rem & 7, rest = rem >> 3, kvh = xcd & 1, idx = (xcd >> 1) + 4 * rest, hq = idx >> 5, qb = idx & 31;
        head = kvh * 4 + hq; t0 = b * SEQL + qb * 256;
        Qp = (const bf16_t*)(p.ws + OFF_QA) + (size_t)t0 * 512 + head * 64;
        Kp = (const bf16_t*)(p.ws + OFF_KA) + (size_t)b * SEQL * 128 + kvh * 64; ldk = 128;
        Vtp = (const bf16_t*)(p.ws + OFF_VTA) + (size_t)(b * 2 + kvh) * 64 * SEQL;
        key0 = 0; ntiles = 128; ocol = head * 64; hslot = head;
    } else {
        head = rem & 7; const int rq = rem >> 3; t0 = b * SEQL + rq * 256;
        Qp = (const bf16_t*)(p.ws + OFF_QB) + (size_t)t0 * 512 + head * 64;
        Kp = (const bf16_t*)(p.ws + OFF_KB) + (size_t)b * SEQL * 512 + head * 64; ldk = 512;
        Vtp = (const bf16_t*)(p.ws + OFF_VTB) + (size_t)(b * 8 + head) * 64 * SEQL;
        const int r0 = 4 * rq, rsA = min(max(r0 - 4, 0), 120), rsB = min(max(r0 - 1, 0), 120);
        krow0 = rsA; key0 = rsA * 64; ntiles = rsB + 8 - rsA; ocol = 512 + head * 64; hslot = 8 + head;
        rw = r0 + (w >> 1); rsw = min(max(rw - 4, 0), 120);
    }
    bf16x8 qf[4];
#pragma unroll
    for (int ks = 0; ks < 4; ++ks) qf[ks] = *(const bf16x8*)(Qp + (size_t)(w * 32 + r) * 512 + ks * 16 + h * 8);
    asm volatile("s_waitcnt vmcnt(0)" ::: "memory");
    __syncthreads();
    if (NAT) {
        LAS float* rl = (LAS float*)(lds + AT_RPB);
        for (int i = tid; i < 64 + 465 + 64; i += 512) rl[i] = (i >= 64 && i < 64 + 465) ? p.rpb[head * 465 + i - 64] * LOG2E : 0.f;
        asm volatile("s_waitcnt vmcnt(0)" ::: "memory");
    }
    const int srow = tid >> 3, slc = (tid & 7) ^ ((srow >> 1) & 7);
    const bf16_t* kg = Kp + (size_t)(key0 + srow) * ldk + slc * 8;
    const bf16_t* vg = Vtp + (size_t)srow * SEQL + key0 + slc * 8;
    const unsigned ldsw = (unsigned)w * 1024u;
#define ISSUE_TILE(tt) do { const int _t = min((tt), ntiles - 1); const int _s = (tt) & (AT_NS - 1); \
        __builtin_amdgcn_global_load_lds((const unsigned*)(kg + (size_t)_t * 64 * ldk), (LAS unsigned*)(lds + _s * AT_STG + ldsw), 16, 0, 0); \
        __builtin_amdgcn_global_load_lds((const unsigned*)(vg + _t * 64), (LAS unsigned*)(lds + _s * AT_STG + 8192 + ldsw), 16, 0, 0); } while (0)
#pragma unroll
    for (int i = 0; i < AT_D - 1; ++i) ISSUE_TILE(i);
    f32x16 o0, o1, cinit;
#pragma unroll
    for (int i = 0; i < 16; ++i) { o0[i] = 0.f; o1[i] = 0.f; cinit[i] = 0.f; }
    float lsum = 0.f;
    bool first = true;
    const int pir = (r & 0x13) | ((r & 4) << 1) | ((r & 8) >> 1);
    int kofs[4], vofs[4];
#pragma unroll
    for (int i = 0; i < 4; ++i) {
        kofs[i] = pir * 128 + (((i * 2 + h) ^ ((pir >> 1) & 7)) << 4);
        vofs[i] = 8192 + r * 128 + (((i * 2 + h) ^ ((r >> 1) & 7)) << 4);
    }
    const int qc = (w & 1) * 32 + r, cs = min(max(qc - 8, 0), 48);
    f32x16 cinitB;
#pragma unroll
    for (int i = 0; i < 16; ++i) cinitB[i] = 0.f;
    if (NAT) {
#pragma unroll
        for (int g = 0; g < 16; ++g) { const int kc0 = 16 * (g >> 3) + 8 * h + (g & 7);
            cinit[g] = ((unsigned)(kc0 - cs) < 16u) ? 0.f : -1e30f; cinitB[g] = ((unsigned)(kc0 + 32 - cs) < 16u) ? 0.f : -1e30f; }
    }
    constexpr float THR = 8.0f;
#define TILE_ACTIVE(t) (!NAT || ((krow0 + (t)) >= rsw && (krow0 + (t)) < rsw + 8))
#define FENCE __builtin_amdgcn_sched_barrier(0x407)
#define QK_TILE(tt, d0, d1) do { LAS unsigned char* _sb = lds + ((tt) & (AT_NS - 1)) * AT_STG; \
        bf16x8 ka0 = *(const LAS bf16x8*)(_sb + kofs[0]), ka1 = *(const LAS bf16x8*)(_sb + kofs[0] + 4096); \
        bf16x8 kb0 = *(const LAS bf16x8*)(_sb + kofs[1]), kb1 = *(const LAS bf16x8*)(_sb + kofs[1] + 4096); \
        FENCE; __builtin_amdgcn_s_setprio(2); \
        d0 = __builtin_amdgcn_mfma_f32_32x32x16_bf16(ka0, qf[0], cinit, 0, 0, 0); d1 = __builtin_amdgcn_mfma_f32_32x32x16_bf16(ka1, qf[0], NAT ? cinitB : cinit, 0, 0, 0); \
        ka0 = *(const LAS bf16x8*)(_sb + kofs[2]); ka1 = *(const LAS bf16x8*)(_sb + kofs[2] + 4096); \
        FENCE; \
        d0 = __builtin_amdgcn_mfma_f32_32x32x16_bf16(kb0, qf[1], d0, 0, 0, 0); d1 = __builtin_amdgcn_mfma_f32_32x32x16_bf16(kb1, qf[1], d1, 0, 0, 0); \
        kb0 = *(const LAS bf16x8*)(_sb + kofs[3]); kb1 = *(const LAS bf16x8*)(_sb + kofs[3] + 4096); \
        FENCE; \
        d0 = __builtin_amdgcn_mfma_f32_32x32x16_bf16(ka0, qf[2], d0, 0, 0, 0); d1 = __builtin_amdgcn_mfma_f32_32x32x16_bf16(ka1, qf[2], d1, 0, 0, 0); \
        FENCE; \
        d0 = __builtin_amdgcn_mfma_f32_32x32x16_bf16(kb0, qf[3], d0, 0, 0, 0); d1 = __builtin_amdgcn_mfma_f32_32x32x16_bf16(kb1, qf[3], d1, 0, 0, 0); \
        __builtin_amdgcn_s_setprio(0); FENCE; } while (0)
#define STEP(T, A0, A1, B0, B1, MODE) do { \
        if (((T) + 1 < ntiles) && TILE_ACTIVE((T) + 1)) QK_TILE((T) + 1, B0, B1); \
        if (TILE_ACTIVE(T)) { \
            LAS unsigned char* sb = lds + ((T) & (AT_NS - 1)) * AT_STG; \
            if (NAT) { \
                const LAS float* rb = (const LAS float*)(lds + AT_RPB) + 64 + (krow0 + (T) - rw + 7) * 31 - qc + 15 + 8 * h; \
                _Pragma("unroll") for (int g = 0; g < 16; ++g) { A0[g] += rb[16 * (g >> 3) + (g & 7)]; A1[g] += rb[32 + 16 * (g >> 3) + (g & 7)]; } \
            } \
            if ((MODE) != 2) { \
            float mx = max3(A0[0], A1[0], A0[1]); \
            mx = max3(mx, A1[1], A0[2]); \
            _Pragma("unroll") for (int i = 2; i < 15; ++i) mx = max3(mx, A1[i], A0[i + 1]); \
            mx = fmaxf(mx, A1[15]); \
            { auto sw = __builtin_amdgcn_permlane32_swap(__float_as_uint(mx), __float_as_uint(mx), false, false); \
              mx = fmaxf(__uint_as_float(sw[0]), __uint_as_float(sw[1])); } \
            if (first || __builtin_amdgcn_ballot_w64(mx > THR) != 0ull) {            \
                asm volatile("" ::: "memory");                                        \
                const float delta = (first || mx > THR) ? mx : 0.f; \
                const float alpha = __builtin_amdgcn_exp2f(-delta); \
                lsum *= alpha; \
                _Pragma("unroll") for (int i = 0; i < 16; ++i) { o0[i] *= alpha; o1[i] *= alpha; A0[i] -= delta; A1[i] -= delta; B0[i] -= delta; B1[i] -= delta; cinit[i] -= delta; if (NAT) cinitB[i] -= delta; } \
                first = false; \
            } \
            } \
            bf16x8 va0 = *(const LAS bf16x8*)(sb + vofs[0]), va1 = *(const LAS bf16x8*)(sb + vofs[0] + 4096); \
            bf16x8 vb0 = *(const LAS bf16x8*)(sb + vofs[1]), vb1 = *(const LAS bf16x8*)(sb + vofs[1] + 4096); \
            FENCE; __builtin_amdgcn_s_setprio(1); \
            float ps = 0.f; \
            _Pragma("unroll") for (int i = 0; i < 16; ++i) { A0[i] = __builtin_amdgcn_exp2f(A0[i]); A1[i] = __builtin_amdgcn_exp2f(A1[i]); ps += A0[i] + A1[i]; } \
            lsum += ps; \
            u32x4 pw; bf16x8 pf; \
            pw.x = pack2(A0[0], A0[1]); pw.y = pack2(A0[2], A0[3]); pw.z = pack2(A0[4], A0[5]); pw.w = pack2(A0[6], A0[7]); pf = __builtin_bit_cast(bf16x8, pw); \
            o0 = __builtin_amdgcn_mfma_f32_32x32x16_bf16(va0, pf, o0, 0, 0, 0); o1 = __builtin_amdgcn_mfma_f32_32x32x16_bf16(va1, pf, o1, 0, 0, 0); \
            va0 = *(const LAS bf16x8*)(sb + vofs[2]); va1 = *(const LAS bf16x8*)(sb + vofs[2] + 4096); \
            FENCE; \
            pw.x = pack2(A0[8], A0[9]); pw.y = pack2(A0[10], A0[11]); pw.z = pack2(A0[12], A0[13]); pw.w = pack2(A0[14], A0[15]); pf = __builtin_bit_cast(bf16x8, pw); \
            o0 = __builtin_amdgcn_mfma_f32_32x32x16_bf16(vb0, pf, o0, 0, 0, 0); o1 = __builtin_amdgcn_mfma_f32_32x32x16_bf16(vb1, pf, o1, 0, 0, 0); \
            vb0 = *(const LAS bf16x8*)(sb + vofs[3]); vb1 = *(const LAS bf16x8*)(sb + vofs[3] + 4096); \
            FENCE; \
            pw.x = pack2(A1[0], A1[1]); pw.y = pack2(A1[2], A1[3]); pw.z = pack2(A1[4], A1[5]); pw.w = pack2(A1[6], A1[7]); pf = __builtin_bit_cast(bf16x8, pw); \
            o0 = __builtin_amdgcn_mfma_f32_32x32x16_bf16(va0, pf, o0, 0, 0, 0); o1 = __builtin_amdgcn_mfma_f32_32x32x16_bf16(va1, pf, o1, 0, 0, 0); \
            FENCE; \
            pw.x = pack2(A1[8], A1[9]); pw.y = pack2(A1[10], A1[11]); pw.z = pack2(A1[12], A1[13]); pw.w = pack2(A1[14], A1[15]); pf = __builtin_bit_cast(bf16x8, pw); \
            o0 = __builtin_amdgcn_mfma_f32_32x32x16_bf16(vb0, pf, o0, 0, 0, 0); o1 = __builtin_amdgcn_mfma_f32_32x32x16_bf16(vb1, pf, o1, 0, 0, 0); \
            __builtin_amdgcn_s_setprio(0); FENCE; \
        } } while (0)
    asm volatile("s_waitcnt vmcnt(10) lgkmcnt(0)" ::: "memory");
    BAR;
    if (STATIC) {
        const float mref = *(const float*)(p.ws + OFF_MREF);
#pragma unroll
        for (int i = 0; i < 16; ++i) cinit[i] = -mref;
        first = false;
    }
    f32x16 s0, s1, n0, n1;
    if (TILE_ACTIVE(0)) QK_TILE(0, s0, s1);
    for (int t = 0; t < ntiles; t += 2) {
        asm volatile("s_waitcnt vmcnt(6) lgkmcnt(0)" ::: "memory");
        BAR;
        ISSUE_TILE(t + 6); ISSUE_TILE(t + 7);
        STEP(t, s0, s1, n0, n1, (STATIC ? 2 : 0)); if (t + 1 < ntiles) STEP(t + 1, n0, n1, s0, s1, (STATIC ? 2 : 0));
    }
#undef STEP
#undef ISSUE_TILE
#undef TILE_ACTIVE
#undef QK_TILE
#undef FENCE
    { auto sw = __builtin_amdgcn_permlane32_swap(__float_as_uint(lsum), __float_as_uint(lsum), false, false);
      lsum = __uint_as_float(sw[0]) + __uint_as_float(sw[1]); }
    const float linv = 1.0f / lsum;
    const int tok = t0 + w * 32 + r;
    bf16_t* od = (bf16_t*)(p.ws + OFF_OMIX) + (size_t)tok * DM + ocol + 4 * h;
    float ss = 0.f;
#pragma unroll
    for (int gq = 0; gq < 4; ++gq) {
        f32x4 a = {o0[gq * 4] * linv, o0[gq * 4 + 1] * linv, o0[gq * 4 + 2] * linv, o0[gq * 4 + 3] * linv};
        f32x4 c = {o1[gq * 4] * linv, o1[gq * 4 + 1] * linv, o1[gq * 4 + 2] * linv, o1[gq * 4 + 3] * linv};
        ss += sq4(a) + sq4(c);
        store4(od + 8 * gq, a); store4(od + 32 + 8 * gq, c);
    }
    ss += __shfl_xor(ss, 32);
    if (h == 0) ((float*)(p.ws + OFF_SSO))[(size_t)tok * 16 + hslot] = ss;
}

DI void phase2(const Params& p, LAS unsigned char* lds) {
    const bool use_static = *(const float*)(p.ws + OFF_MREF) <= 40.0f;
    for (int u = blockIdx.x; u < 2048; u += gridDim.x) {
        if (u < 1024) { if (use_static) attn_unit<false, true>(p, u, lds); else attn_unit<false, false>(p, u, lds); }
        else attn_unit<true, false>(p, u - 1024, lds);
    }
}

struct EpiOut {
    static constexpr bool HAS_PREP = true, HAS_MID = true; static constexpr int MID_T = 8;
    const float* x; float* out; unsigned char* ws;
    DI void prep(const Unit& u, tab_t tab) const {
        const int tid = threadIdx.x;
        if (tid < 256) {
            const f32x4* s = (const f32x4*)((const float*)(ws + OFF_SSO) + (size_t)(u.pm * BM + tid) * 16);
            const float sa = sum4(s[0]) + sum4(s[1]), sb = sum4(s[2]) + sum4(s[3]);
            const float ra = rsqrtf(sa * (1.0f / 512.0f) + EPS), rb = rsqrtf(sb * (1.0f / 512.0f) + EPS);
            tab[tid] = (f32x2){ra / rb, rb};
        }
    }
    DI void mid(f32x4 (&acc)[2][2][4][2], tab_t tab, int wr, int fr) const {
#pragma unroll
        for (int ai = 0; ai < 2; ++ai)
#pragma unroll
            for (int m = 0; m < 4; ++m) {
                const float rt = tab[ai * HALF + wr * 64 + m * 16 + fr].x;
#pragma unroll
                for (int bj = 0; bj < 2; ++bj)
#pragma unroll
                    for (int n = 0; n < 2; ++n) acc[ai][bj][m][n] *= rt;
            }
    }
    DI void operator()(f32x4 (&acc)[2][2][4][2], const Unit& u, tab_t tab, int wr, int wc, int fr, int fq, LAS unsigned char*) const {
        bf16_t* x1b = (bf16_t*)(ws + OFF_X1B);
        float* ss2 = (float*)(ws + OFF_SS2);
#pragma unroll
        for (int ai = 0; ai < 2; ++ai) {
            f32x4 xv[4][2][2];
#pragma unroll
            for (int m = 0; m < 4; ++m) {
                const size_t off = (size_t)(u.pm * BM + ai * HALF + wr * 64 + m * 16 + fr) * DM + u.pn * BM + wc * 32 + fq * 8;
#pragma unroll
                for (int bj = 0; bj < 2; ++bj)
#pragma unroll
                    for (int n = 0; n < 2; ++n) xv[m][bj][n] = *(const f32x4*)(x + off + bj * HALF + n * 4);
            }
#pragma unroll
            for (int m = 0; m < 4; ++m) {
                const int rl = ai * HALF + wr * 64 + m * 16 + fr, t = u.pm * BM + rl;
                const float rb = tab[rl].y;
                const size_t off = (size_t)t * DM + u.pn * BM + wc * 32 + fq * 8;
                float ss = 0.f;
#pragma unroll
                for (int bj = 0; bj < 2; ++bj) {
                    const f32x4 v0 = xv[m][bj][0] + acc[ai][bj][m][0] * rb, v1 = xv[m][bj][1] + acc[ai][bj][m][1] * rb;
                    ss += sq4(v0) + sq4(v1);
                    store8(x1b + off + bj * HALF, v0, v1);
                }
                ss += __shfl_xor(ss, 16); ss += __shfl_xor(ss, 32);
                if (fq == 0) ss2[(size_t)t * 16 + u.pn * 4 + wc] = ss;
            }
            asm volatile("" ::: "memory");
        }
    }
};
DI void phase3(const Params& p, LAS unsigned char* lds) {
    StaticOrder S; S.init(NTOK, DM, gridDim.x, blockIdx.x);
    Gemm g{(const bf16_t*)(p.ws + OFF_OMIX), (const bf16_t*)(p.ws + OFF_WT_OUT), DM};
    EpiOut E{p.x, p.out, p.ws};
    gemm_phase<EpiOut, StaticOrder>(lds, g, S, E);
}

struct EpiGU {
    static constexpr bool HAS_PREP = true, HAS_MID = false; static constexpr int MID_T = -1;
    unsigned char* ws;
    DI void prep(const Unit& u, tab_t tab) const {
        const int tid = threadIdx.x;
        if (tid < 256) {
            const f32x4* s = (const f32x4*)((const float*)(ws + OFF_SS2) + (size_t)(u.pm * BM + tid) * 16);
            const float sa = (sum4(s[0]) + sum4(s[1])) + (sum4(s[2]) + sum4(s[3]));
            tab[tid] = (f32x2){rsqrtf(sa * (1.0f / DM) + EPS), 0.f};
        }
    }
    DI void mid(f32x4 (&)[2][2][4][2], tab_t, int, int) const {}
    DI void operator()(f32x4 (&acc)[2][2][4][2], const Unit& u, tab_t tab, int wr, int wc, int fr, int fq, LAS unsigned char*) const {
        bf16_t* hbuf = (bf16_t*)(ws + OFF_H);
#pragma unroll
        for (int ai = 0; ai < 2; ++ai)
#pragma unroll
            for (int m = 0; m < 4; ++m) {
                const int rl = ai * HALF + wr * 64 + m * 16 + fr;
                const float rs = tab[rl].x;
                bf16_t* d = hbuf + (size_t)(u.pm * BM + rl) * DFF + u.pn * 128 + wc * 32 + fq * 8;
                f32x4 o[2];
#pragma unroll
                for (int n = 0; n < 2; ++n) {
#pragma unroll
                    for (int j = 0; j < 4; ++j) {
                        const float g = acc[ai][0][m][n][j] * rs, uu = acc[ai][1][m][n][j] * rs;
                        o[n][j] = g * uu * __builtin_amdgcn_rcpf(1.0f + __builtin_amdgcn_exp2f(-g * LOG2E));
                    }
                }
                store8(d, o[0], o[1]);
            }
    }
};
DI void phase4(const Params& p, LAS unsigned char* lds) {
    StaticOrder S; S.init(NTOK, 2 * DFF, gridDim.x, blockIdx.x);
    Gemm g{(const bf16_t*)(p.ws + OFF_X1B), (const bf16_t*)(p.ws + OFF_WT_GU), DM};
    EpiGU E{p.ws};
    gemm_phase<EpiGU, StaticOrder>(lds, g, S, E);
}

struct EpiDown {
    static constexpr bool HAS_PREP = false, HAS_MID = false; static constexpr int MID_T = -1;
    float* out; unsigned char* ws; const float* gfin;
    DI void prep(const Unit&, tab_t) const {}
    DI void mid(f32x4 (&)[2][2][4][2], tab_t, int, int) const {}
    DI void operator()(f32x4 (&acc)[2][2][4][2], const Unit& u, tab_t, int wr, int wc, int fr, int fq, LAS unsigned char* lds) const {
        const bf16_t* x1b = (const bf16_t*)(ws + OFF_X1B);
        float* xbuf = (float*)(ws + OFF_XBUF);
        unsigned* cnt = (unsigned*)(ws + OFF_PCNT) + 64 * u.pm;
        LAS float* P = (LAS float*)(lds + TAB_OFF);
        LAS float* S = (LAS float*)(lds + TAB_OFF + 4096);
        const int tid = threadIdx.x;
#pragma unroll
        for (int ai = 0; ai < 2; ++ai) {
            u32x4 xv[4][2];
#pragma unroll
            for (int m = 0; m < 4; ++m) {
                const size_t off = (size_t)(u.pm * BM + ai * HALF + wr * 64 + m * 16 + fr) * DM + u.pn * BM + wc * 32 + fq * 8;
#pragma unroll
                for (int bj = 0; bj < 2; ++bj) xv[m][bj] = *(const u32x4*)(x1b + off + bj * HALF);
            }
#pragma unroll
            for (int m = 0; m < 4; ++m) {
                float ss = 0.f;
#pragma unroll
                for (int bj = 0; bj < 2; ++bj) {
                    const u32x4 w = xv[m][bj];
                    const f32x4 x0 = {__uint_as_float(w.x << 16), __uint_as_float(w.x & 0xffff0000u), __uint_as_float(w.y << 16), __uint_as_float(w.y & 0xffff0000u)};
                    const f32x4 x1 = {__uint_as_float(w.z << 16), __uint_as_float(w.z & 0xffff0000u), __uint_as_float(w.w << 16), __uint_as_float(w.w & 0xffff0000u)};
                    acc[ai][bj][m][0] += x0; acc[ai][bj][m][1] += x1;
                    ss += sq4(acc[ai][bj][m][0]) + sq4(acc[ai][bj][m][1]);
                }
                ss += __shfl_xor(ss, 16); ss += __shfl_xor(ss, 32);
                if (fq == 0) P[(ai * HALF + wr * 64 + m * 16 + fr) * 4 + wc] = ss;
            }
            asm volatile("" ::: "memory");
        }
        asm volatile("s_waitcnt lgkmcnt(0)" ::: "memory"); BAR; asm volatile("" ::: "memory");
        if (tid < 256) {
            const f32x4 pp = *(const LAS f32x4*)(P + tid * 4);
            __hip_atomic_store(xbuf + (size_t)(u.pm * BM + tid) * 4 + u.pn, (pp[0] + pp[1]) + (pp[2] + pp[3]), __ATOMIC_RELAXED, __HIP_MEMORY_SCOPE_AGENT);
            asm volatile("s_waitcnt vmcnt(0)" ::: "memory");
            if ((tid & 63) == 0) __hip_atomic_fetch_add(cnt, 1u, __ATOMIC_RELAXED, __HIP_MEMORY_SCOPE_AGENT);
        }
        if (tid < 64) {
            for (unsigned it = 0; (unsigned)__builtin_amdgcn_readfirstlane((int)__hip_atomic_load(cnt, __ATOMIC_RELAXED, __HIP_MEMORY_SCOPE_AGENT)) < 16u && it < (1u << 22); ++it) __builtin_amdgcn_s_sleep(2);
            __builtin_amdgcn_fence(__ATOMIC_ACQUIRE, "agent");
            asm volatile("s_waitcnt vmcnt(0)" ::: "memory");
        }
        asm volatile("s_waitcnt vmcnt(0) lgkmcnt(0)" ::: "memory"); BAR; asm volatile("" ::: "memory");
        if (tid < 256) {
            const unsigned long long* slot = (const unsigned long long*)(xbuf + (size_t)(u.pm * BM + tid) * 4);
            const unsigned long long w0 = __hip_atomic_load(slot, __ATOMIC_RELAXED, __HIP_MEMORY_SCOPE_AGENT), w1 = __hip_atomic_load(slot + 1, __ATOMIC_RELAXED, __HIP_MEMORY_SCOPE_AGENT);
            const float q = (__uint_as_float((unsigned)w0) + __uint_as_float((unsigned)(w0 >> 32))) + (__uint_as_float((unsigned)w1) + __uint_as_float((unsigned)(w1 >> 32)));
            S[tid] = rsqrtf(q * (1.0f / DM) + EPS);
        }
        asm volatile("s_waitcnt lgkmcnt(0)" ::: "memory"); BAR; asm volatile("" ::: "memory");
        f32x4 gv[2][2];
#pragma unroll
        for (int bj = 0; bj < 2; ++bj)
#pragma unroll
            for (int n = 0; n < 2; ++n) gv[bj][n] = *(const f32x4*)(gfin + u.pn * BM + bj * HALF + wc * 32 + fq * 8 + n * 4);
#pragma unroll
        for (int ai = 0; ai < 2; ++ai)
#pragma unroll
            for (int m = 0; m < 4; ++m) {
                const int rl = ai * HALF + wr * 64 + m * 16 + fr;
                const float rs = S[rl];
                float* o = out + (size_t)(u.pm * BM + rl) * DM + u.pn * BM + wc * 32 + fq * 8;
#pragma unroll
                for (int bj = 0; bj < 2; ++bj) {
                    *(f32x4*)(o + bj * HALF) = acc[ai][bj][m][0] * rs * gv[bj][0];
                    *(f32x4*)(o + bj * HALF + 4) = acc[ai][bj][m][1] * rs * gv[bj][1];
                }
            }
    }
};
DI void phase5(const Params& p, LAS unsigned char* lds) {
    StaticOrder S; S.init(NTOK, DM, gridDim.x, blockIdx.x);
    Gemm g{(const bf16_t*)(p.ws + OFF_H), (const bf16_t*)(p.ws + OFF_WT_DN), DFF};
    EpiDown E{p.out, p.ws, p.norm_final};
    gemm_phase<EpiDown, StaticOrder>(lds, g, S, E);
}

#define XB_TMO      128
#define XB_XCNT(j)  (256  + 64 * (j))
#define XB_XSUB(j)  (1280 + 64 * (j))
#define XB_XGEN(j)  (2304 + 64 * (j))
#define XB_TOP      3328
#define XB_TOPGEN   3392
#define XCD_BAR_WORDS 3456
#define XB_SPIN_CAP (1u << 20)
DI unsigned xb_ld(unsigned* p)              { return __hip_atomic_load(p, __ATOMIC_RELAXED, __HIP_MEMORY_SCOPE_AGENT); }
DI unsigned xb_add(unsigned* p, unsigned v) { return __hip_atomic_fetch_add(p, v, __ATOMIC_RELAXED, __HIP_MEMORY_SCOPE_AGENT); }
DI unsigned xb_xcc_id() { return (unsigned)__builtin_amdgcn_s_getreg((3 << 11) | 20) & 0xFu; }
#define XB_SPIN(cond, bar) do { unsigned _sp = 0; while (cond) { __builtin_amdgcn_s_sleep(1); \
    if ((++_sp & 255u) == 0u) { if (xb_ld(&(bar)[XB_TMO])) break; if (_sp > XB_SPIN_CAP) { xb_add(&(bar)[XB_TMO], 1u); break; } } } } while (0)
struct XcdBarrier { unsigned* bar; unsigned x; volatile LAS unsigned* st; };
DI XcdBarrier xcd_barrier_post(unsigned* bar, volatile LAS unsigned* st) {
    XcdBarrier b; b.bar = bar; b.x = xb_xcc_id(); b.st = st;
    if (threadIdx.x == 0) (void)xb_add(&bar[XB_XCNT(b.x)], 1u);
    return b;
}
DI void xcd_barrier_complete(unsigned* bar, unsigned x, unsigned& nloc, unsigned& nx) {
    const unsigned G = gridDim.x;
    unsigned sum, cnt, mine, sp = 0u;
    for (;;) {
        sum = 0u; cnt = 0u; mine = 0u;
#pragma unroll
        for (unsigned j = 0; j < 16; ++j) { const unsigned c = xb_ld(&bar[XB_XCNT(j)]); sum += c; cnt += (c > 0u) ? 1u : 0u; mine = (j == x) ? c : mine; }
        if (sum == G) break;
        __builtin_amdgcn_s_sleep(1);
        if ((++sp & 255u) == 0u) { if (xb_ld(&bar[XB_TMO])) break; if (sp > XB_SPIN_CAP) { xb_add(&bar[XB_TMO], 1u); break; } }
    }
    nloc = mine > 0u ? mine : 1u; nx = cnt > 0u ? cnt : 1u;
}
DI void grid_barrier(const XcdBarrier& b) {
    asm volatile("s_waitcnt vmcnt(0) lgkmcnt(0)" ::: "memory");
    __syncthreads();
    if (threadIdx.x == 0) {
        unsigned* bar = b.bar;
        unsigned nloc = b.st[0], nx = b.st[1];
        if (nloc == 0u) { xcd_barrier_complete(bar, b.x, nloc, nx); b.st[0] = nloc; b.st[1] = nx; }
        const unsigned old = xb_add(&bar[XB_XSUB(b.x)], 1u);
        const unsigned gen = old / nloc;
        if (old + 1u == (gen + 1u) * nloc) {
            __builtin_amdgcn_fence(__ATOMIC_RELEASE, "agent");
            asm volatile("s_waitcnt vmcnt(0)" ::: "memory");
            const unsigned og = xb_add(&bar[XB_TOP], 1u);
            const unsigned tg = og / nx;
            if (og + 1u == (tg + 1u) * nx) xb_add(&bar[XB_TOPGEN], 1u);
            else XB_SPIN(xb_ld(&bar[XB_TOPGEN]) == tg, bar);
            __builtin_amdgcn_fence(__ATOMIC_ACQUIRE, "agent");
            xb_add(&bar[XB_XGEN(b.x)], 1u);
            asm volatile("s_waitcnt vmcnt(0)" ::: "memory");
        } else {
            XB_SPIN(xb_ld(&bar[XB_XGEN(b.x)]) == gen, bar);
            __builtin_amdgcn_fence(__ATOMIC_ACQUIRE, "agent");
            asm volatile("s_waitcnt vmcnt(0)" ::: "memory");
        }
    }
    __syncthreads();
}

constexpr int LDS_BYTES = STAGE_BYTES + 8192;
__global__ void __launch_bounds__(512, 2) mega(Params p, int ph_lo, int ph_hi) {
    extern __shared__ __attribute__((aligned(16))) unsigned char lds_raw[];
    LAS unsigned char* lds = (LAS unsigned char*)lds_raw;
    volatile LAS unsigned* xst = (volatile LAS unsigned*)(lds + TAB_OFF + 8176);
    if (threadIdx.x == 0) { xst[0] = 0u; xst[1] = 0u; }
    __syncthreads();
    const XcdBarrier xb = xcd_barrier_post((unsigned*)(p.ws + OFF_BAR), xst);
    if (ph_lo < 0) cg::this_grid().sync();
#define PHASE(n, call) if (ph_lo <= (n) && (n) < ph_hi) { call; if ((n) + 1 < ph_hi) grid_barrier(xb); }
    PHASE(0, phase0(p, lds))
    PHASE(1, phase1(p, lds))
    PHASE(2, phase2(p, lds))
#ifdef PROBE_DUP2
    PHASE(2, phase2(p, lds))
#endif
    PHASE(3, phase3(p, lds))
#ifdef PROBE_DUP3
    PHASE(3, phase3(p, lds))
#endif
    PHASE(4, phase4(p, lds))
#ifdef PROBE_DUP4
    PHASE(4, phase4(p, lds))
#endif
    PHASE(5, phase5(p, lds))
#undef PHASE
}

extern "C" void kernel_launch(void* const* d_in, const int* in_sizes, int n_in, void* d_out, int out_size, void* d_ws, size_t ws_size,
                              hipStream_t stream) {
    static int grid_blocks = 0;
    if (!grid_blocks) {
        int dev = 0, cus = 0, per_cu = 0;
        (void)hipGetDevice(&dev);
        (void)hipDeviceGetAttribute(&cus, hipDeviceAttributeMultiprocessorCount, dev);
        (void)hipFuncSetAttribute((const void*)mega, hipFuncAttributeMaxDynamicSharedMemorySize, LDS_BYTES);
        (void)hipOccupancyMaxActiveBlocksPerMultiprocessor(&per_cu, (const void*)mega, 512, LDS_BYTES);
        if (per_cu < 1) per_cu = 1;
        if (per_cu > 1) per_cu = 1;
        grid_blocks = cus * per_cu;
    }
    Params p{};
    p.x = (const float*)d_in[0]; p.norm_mix = (const float*)d_in[1]; p.w_in = (const float*)d_in[2]; p.q_norm_a = (const float*)d_in[3];
    p.k_norm_a = (const float*)d_in[4]; p.rpb = (const float*)d_in[5]; p.out_norm_a = (const float*)d_in[6]; p.out_norm_b = (const float*)d_in[7];
    p.w_out = (const float*)d_in[8]; p.norm_ffn = (const float*)d_in[9]; p.w_gate = (const float*)d_in[10]; p.w_up = (const float*)d_in[11];
    p.w_down = (const float*)d_in[12]; p.norm_final = (const float*)d_in[13];
    p.out = (float*)d_out; p.ws = (unsigned char*)d_ws;
    int lo = 0, hi = 6;
    void* args[] = {&p, &lo, &hi};
    (void)hipMemsetAsync((unsigned char*)d_ws + OFF_BAR, 0, 16384 + 128 * 256, stream);
    hipError_t e = hipLaunchCooperativeKernel((const void*)mega, dim3(grid_blocks), dim3(512), args, LDS_BYTES, stream);
    if (e != hipSuccess) fprintf(stderr, "cooperative launch failed: %s (grid %d)\n", hipGetErrorString(e), grid_blocks);
}
```

```cpp
#include <hip/hip_runtime.h>
#include <hip/hip_cooperative_groups.h>
#include <cstdio>
#include <cstdint>
namespace cg = cooperative_groups;

#define LAS __attribute__((address_space(3)))
#define DI __device__ __forceinline__
typedef unsigned short bf16_t;
typedef short bf16x8 __attribute__((ext_vector_type(8)));
typedef float f32x4 __attribute__((ext_vector_type(4)));
typedef float f32x2 __attribute__((ext_vector_type(2)));
typedef float f32x16 __attribute__((ext_vector_type(16)));
typedef unsigned u32x4 __attribute__((ext_vector_type(4)));
typedef unsigned u32x2 __attribute__((ext_vector_type(2)));

constexpr int NTOK = 32768, DM = 1024, SEQL = 8192, INW = 2304, DFF = 2816;
constexpr float EPS = 1e-6f;
constexpr float LOG2E = 1.4426950408889634f;
constexpr float QSCALE = 0.125f * LOG2E;

constexpr size_t OFF_WT_IN = 0;
constexpr size_t OFF_WT_OUT = OFF_WT_IN + (size_t)INW * DM * 2;
constexpr size_t OFF_WT_GU = OFF_WT_OUT + (size_t)DM * DM * 2;
constexpr size_t OFF_WT_DN = OFF_WT_GU + (size_t)2 * DFF * DM * 2;
constexpr size_t OFF_ROPE = OFF_WT_DN + (size_t)DM * DFF * 2;
constexpr size_t OFF_SSO = OFF_ROPE + 128 * 16 * 8;
constexpr size_t OFF_SS2 = OFF_SSO + (size_t)NTOK * 16 * 4;
constexpr size_t OFF_SS3 = OFF_SS2 + (size_t)NTOK * 16 * 4;
constexpr size_t OFF_OMIX = OFF_SS3 + (size_t)NTOK * 16 * 4;
constexpr size_t OFF_X1B = OFF_OMIX + (size_t)NTOK * DM * 2;
constexpr size_t OFF_XN = OFF_X1B + (size_t)NTOK * DM * 2;
constexpr size_t OFF_QA = OFF_XN + (size_t)NTOK * DM * 2;
constexpr size_t OFF_KA = OFF_QA + (size_t)NTOK * 512 * 2;
constexpr size_t OFF_VTA = OFF_KA + (size_t)NTOK * 128 * 2;
constexpr size_t OFF_QB = OFF_VTA + (size_t)NTOK * 128 * 2;
constexpr size_t OFF_KB = OFF_QB + (size_t)NTOK * 512 * 2;
constexpr size_t OFF_VTB = OFF_KB + (size_t)NTOK * 512 * 2;
constexpr size_t OFF_BAR = OFF_VTB + (size_t)NTOK * 512 * 2;
constexpr size_t OFF_PCNT = OFF_BAR + 16384;
constexpr size_t OFF_XBUF = OFF_PCNT + 128 * 256;
constexpr size_t OFF_MREF = OFF_XBUF + (size_t)NTOK * 4 * 4;
constexpr size_t OFF_H = OFF_XN;
static_assert(OFF_VTB + (size_t)NTOK * 512 * 2 - OFF_XN >= (size_t)NTOK * DFF * 2, "h overlay does not fit");

struct Params {
    const float *x, *norm_mix, *w_in, *q_norm_a, *k_norm_a, *rpb, *out_norm_a, *out_norm_b, *w_out, *norm_ffn, *w_gate, *w_up, *w_down, *norm_final;
    float* out;
    unsigned char* ws;
};

typedef __bf16 bf16x2_t __attribute__((ext_vector_type(2)));
DI unsigned pack2(float lo, float hi) { const f32x2 v = {lo, hi}; return __builtin_bit_cast(unsigned, __builtin_convertvector(v, bf16x2_t)); }
#define WAIT_V(n) asm volatile("s_waitcnt vmcnt(" #n ")" ::: "memory")
#define BAR __builtin_amdgcn_s_barrier()

constexpr int BM = 256, BK = 64, HALF = 128, HTB = HALF * BK * 2, STAGE_BYTES = 8 * HTB, NXCD = 8, WGM = 8;
constexpr int TAB_OFF = STAGE_BYTES;
DI int lds_byte(int r, int c) { const int st = (r >> 4) * 2 + (c >> 5), rr = r & 15, cc = c & 31, ob = rr * 64 + cc * 2; return st * 1024 + (ob ^ (((ob >> 9) & 1) << 5)); }
DI void stage_rc(int b, int& R, int& C) { const int st = b / 1024, sb = b % 1024, swz = sb ^ (((sb >> 9) & 1) << 5); R = (st >> 1) * 16 + swz / 64; C = (st & 1) * 32 + (swz % 64) / 2; }
struct Unit { int pm, pn, hn; };
struct Gemm { const bf16_t* A; const bf16_t* Bt; int K; };
struct StaticOrder {
    int nM, nN, nwg, G, c;
    DI void init(int M, int N, int G_, int c_) { nM = M / BM; nN = N / BM; nwg = nM * nN; G = G_; c = c_; }
    DI bool next(int i, Unit& u) const {
        const long L = (long)i * G + c; if (L >= nwg) return false;
        int wgid = (int)L; { const int q = nwg / NXCD, r = nwg % NXCD, xcd = wgid % NXCD, off = wgid / NXCD; wgid = (xcd < r ? xcd * (q + 1) : r * (q + 1) + (xcd - r) * q) + off; }
        const int nig = WGM * nN, gid = wgid / nig, fm = gid * WGM, gsz = (nM - fm) < WGM ? (nM - fm) : WGM;
        u.pm = fm + ((wgid % nig) % gsz); u.pn = (wgid % nig) / gsz; u.hn = 0; return true;
    }
};
struct QkvOrder {
    StaticOrder S8; int G, c;
    DI void init(int G_, int c_) { S8.init(NTOK, 8 * BM, G_, c_); G = G_; c = c_; }
    DI bool next(int i, Unit& u) const {
        const long L = (long)i * G + c;
        if (L < 1024) return S8.next(i, u);
        const int h = (int)L - 1024; if (h >= 256) return false;
        u.pm = h >> 1; u.pn = 8; u.hn = 1 + (h & 1); return true;
    }
};
typedef LAS f32x2* tab_t;

template <class Epi, class Sched>
DI void gemm_phase(LAS unsigned char* lds, const Gemm g, const Sched& S, const Epi& E) {
    const int tid = threadIdx.x, wid = __builtin_amdgcn_readfirstlane(tid >> 6), lane = tid & 63, wr = wid >> 2, wc = wid & 3, fr = lane & 15, fq = lane >> 4;
    const int K = g.K, nt = K / BK;
    unsigned voffA[2];
#pragma unroll
    for (int i = 0; i < 2; ++i) { int R, C; stage_rc(tid * 16 + i * 8192, R, C); voffA[i] = (unsigned)(R * K + C) * 2u; }
    const size_t kstep = (size_t)(BK * 2), hstep = (size_t)HALF * K * 2, tstep = 2 * hstep;
    const unsigned ldsw = (unsigned)wid * 1024u;
    const int aoff = lds_byte(wr * 64 + fr, fq * 8), boff = lds_byte(wc * 32 + fr, fq * 8);
#define G_SA(b, h) (((b) * 2 + (h)) * HTB)
#define G_SB(b, h) ((4 + (b) * 2 + (h)) * HTB)
#define G_STAGE(bufoff, gbase) do { _Pragma("unroll") for (int _i = 0; _i < 2; ++_i) \
        __builtin_amdgcn_global_load_lds((const unsigned*)((const char*)(gbase) + voffA[_i]), (LAS unsigned*)(lds + (bufoff) + ldsw + _i * 8192), 16, 0, 0); } while (0)
#define G_LDA(dst, b, h) do { _Pragma("unroll") for (int m = 0; m < 4; ++m) _Pragma("unroll") for (int k = 0; k < 2; ++k) dst[m][k] = *(const LAS bf16x8*)(lds + G_SA(b, h) + aoff + m * 2048 + k * 1024); } while (0)
#define G_LDB(dst, b, h) do { _Pragma("unroll") for (int n = 0; n < 2; ++n) _Pragma("unroll") for (int k = 0; k < 2; ++k) dst[n][k] = *(const LAS bf16x8*)(lds + G_SB(b, h) + boff + n * 2048 + k * 1024); } while (0)
#define G_MMA(ai, bj, At, Bt) do { __builtin_amdgcn_s_setprio(1); _Pragma("unroll") for (int m = 0; m < 4; ++m) _Pragma("unroll") for (int n = 0; n < 2; ++n) _Pragma("unroll") for (int k = 0; k < 2; ++k) \
        acc[ai][bj][m][n] = __builtin_amdgcn_mfma_f32_16x16x32_bf16(Bt[n][k], At[m][k], acc[ai][bj][m][n], 0, 0, 0); __builtin_amdgcn_s_setprio(0); } while (0)
#define G_WAIT_L(n) asm volatile("s_waitcnt lgkmcnt(" #n ")" ::: "memory")
#define G_SCHED __builtin_amdgcn_sched_barrier(0)
    Unit cur, nxt; int ui = 0;
    if (!S.next(0, cur)) return;
    f32x4 acc[2][2][4][2];
#pragma unroll
    for (int a = 0; a < 2; ++a)
#pragma unroll
        for (int b = 0; b < 2; ++b)
#pragma unroll
            for (int m = 0; m < 4; ++m)
#pragma unroll
                for (int n = 0; n < 2; ++n) acc[a][b][m][n] = (f32x4){0.f, 0.f, 0.f, 0.f};
    bf16x8 At[4][2], B0[2][2], B1[2][2];
    const char* cA = (const char*)g.A + (size_t)cur.pm * tstep; const char* cB = (const char*)g.Bt + (size_t)cur.pn * tstep + (cur.hn == 2 ? hstep : 0);
    if (Epi::HAS_PREP) { E.prep(cur, (tab_t)(lds + TAB_OFF)); WAIT_V(0); }
    G_STAGE(G_SB(0, 0), cB); G_STAGE(G_SB(0, 1), cB + hstep); G_STAGE(G_SA(0, 0), cA); G_STAGE(G_SA(0, 1), cA + hstep);
    if (wr == 1) BAR;
    WAIT_V(2); BAR;
    G_STAGE(G_SB(1, 0), cB + kstep); G_STAGE(G_SA(1, 0), cA + kstep); G_STAGE(G_SB(1, 1), cB + hstep + kstep);
    WAIT_V(6); BAR;
    for (;;) {
        const bool has_next = S.next(ui + 1, nxt);
        const char* nA = has_next ? (const char*)g.A + (size_t)nxt.pm * tstep : cA; const char* nB = has_next ? (const char*)g.Bt + (size_t)nxt.pn * tstep + (nxt.hn == 2 ? hstep : 0) : cB;
        tab_t tab = (tab_t)(lds + TAB_OFF + (ui & 1) * 2048);
        const bool fullw = cur.hn == 0;
        for (int t = 0; t < nt; t += 2) {
            const bool last = (t == nt - 2);
            const char* a1 = cA + (size_t)(t + 1) * kstep;
            const char* a2 = last ? nA : cA + (size_t)(t + 2) * kstep; const char* b2 = last ? nB : cB + (size_t)(t + 2) * kstep;
            const char* a3 = a2 + kstep; const char* b3 = b2 + kstep;
            if (Epi::HAS_MID) { if (t == Epi::MID_T) E.mid(acc, tab, wr, fr); }
            G_LDB(B0, 0, 0); G_LDB(B1, 0, 1); G_SCHED; G_LDA(At, 0, 0); G_STAGE(G_SA(1, 1), a1 + hstep);
            WAIT_V(8); G_WAIT_L(0); BAR; G_MMA(0, 0, At, B0); if (fullw) G_MMA(0, 1, At, B1); BAR; G_SCHED;
            G_LDA(At, 0, 1); G_STAGE(G_SB(0, 0), b2); G_STAGE(G_SB(0, 1), b2 + hstep); G_STAGE(G_SA(0, 0), a2);
            WAIT_V(8); G_WAIT_L(0); BAR; G_MMA(1, 0, At, B0); if (fullw) G_MMA(1, 1, At, B1); BAR; G_SCHED;
            G_LDB(B0, 1, 0); G_LDB(B1, 1, 1); G_SCHED; G_LDA(At, 1, 0); G_STAGE(G_SA(0, 1), a2 + hstep);
            WAIT_V(8); G_WAIT_L(0); BAR; G_MMA(0, 0, At, B0); if (fullw) G_MMA(0, 1, At, B1); BAR; G_SCHED;
            G_LDA(At, 1, 1); G_STAGE(G_SB(1, 0), b3); G_STAGE(G_SB(1, 1), b3 + hstep); G_STAGE(G_SA(1, 0), a3);
            WAIT_V(8); G_WAIT_L(0); BAR; G_MMA(1, 0, At, B0); if (fullw) G_MMA(1, 1, At, B1); BAR; G_SCHED;
        }
        if (wr == 0) BAR;
        E(acc, cur, tab, wr, wc, fr, fq, lds);
        if (!has_next) break;
#pragma unroll
        for (int a = 0; a < 2; ++a)
#pragma unroll
            for (int b = 0; b < 2; ++b)
#pragma unroll
                for (int m = 0; m < 4; ++m)
#pragma unroll
                    for (int n = 0; n < 2; ++n) acc[a][b][m][n] = (f32x4){0.f, 0.f, 0.f, 0.f};
        cur = nxt; cA = nA; cB = nB; ++ui;
        if (Epi::HAS_PREP) E.prep(cur, (tab_t)(lds + TAB_OFF + (ui & 1) * 2048));
        if (wr == 1) BAR;
    }
    WAIT_V(0);
    BAR;
#undef G_SA
#undef G_SB
#undef G_STAGE
#undef G_LDA
#undef G_LDB
#undef G_MMA
#undef G_WAIT_L
#undef G_SCHED
}

DI void store4(bf16_t* dst, f32x4 v) { u32x2 w; w.x = pack2(v[0], v[1]); w.y = pack2(v[2], v[3]); *(u32x2*)dst = w; }
DI void store8(bf16_t* dst, f32x4 a, f32x4 b) { u32x4 w; w.x = pack2(a[0], a[1]); w.y = pack2(a[2], a[3]); w.z = pack2(b[0], b[1]); w.w = pack2(b[2], b[3]); *(u32x4*)dst = w; }
DI void store1(bf16_t* dst, float v) { *dst = (bf16_t)(pack2(v, v) & 0xffffu); }
DI float sum4(f32x4 a) { return (a[0] + a[1]) + (a[2] + a[3]); }
DI float sq4(f32x4 a) { return (a[0] * a[0] + a[1] * a[1]) + (a[2] * a[2] + a[3] * a[3]); }

DI int perm_slot(int f) { const int q = f & 31; return (f & ~31) | (((q >> 2) & 1) << 4) | ((q >> 3) << 2) | (q & 3); }
DI int map_row(int f, int rowmap) {
    if (rowmap == 0) return perm_slot(f);
    if (rowmap == 1) return (f >> 7) * 256 + perm_slot(f & 127);
    if (rowmap == 2) return (f >> 7) * 256 + 128 + perm_slot(f & 127);
    if (f >= 1792) return f;
    if (f >= 768) return perm_slot(f);
    const int pn = f >> 8, w = f & 255;
    return pn * 256 + ((w >> 5) & 1) * 128 + (w >> 6) * 32 + (w & 31);
}
DI void transpose_tile(const float* __restrict__ src, int N, int k0, int n0, const float* __restrict__ gA, const float* __restrict__ gB, int gsplit,
                       bf16_t* __restrict__ dst, int ldd, int rowmap, LAS unsigned char* lds) {
    const int tid = threadIdx.x, n = tid & 63, kq = tid >> 6;
    LAS unsigned* t32 = (LAS unsigned*)lds;
#pragma unroll
    for (int i = 0; i < 4; ++i) {
        const int k = kq * 8 + 2 * i, kg = k0 + k;
        float g0 = 1.f, g1 = 1.f;
        if (gA) { g0 = kg < gsplit ? gA[kg] : gB[kg - gsplit]; g1 = (kg + 1) < gsplit ? gA[kg + 1] : gB[kg + 1 - gsplit]; }
        const float v0 = src[(size_t)kg * N + n0 + n] * g0, v1 = src[(size_t)(kg + 1) * N + n0 + n] * g1;
        t32[n * 36 + (k >> 1)] = pack2(v0, v1);
    }
    __syncthreads();
    {
        const int nn = tid >> 3, ch = tid & 7;
        const u32x4 v = *(const LAS u32x4*)(lds + nn * 144 + ch * 16);
        *(u32x4*)(dst + (size_t)map_row(n0 + nn, rowmap) * ldd + k0 + ch * 8) = v;
    }
    __syncthreads();
}

DI float wave_sum(float v) {
#pragma unroll
    for (int o = 32; o >= 1; o >>= 1) v += __shfl_xor(v, o);
    return v;
}

DI void phase0(const Params& p, LAS unsigned char* lds) {
    bf16_t* wt_in = (bf16_t*)(p.ws + OFF_WT_IN);
    bf16_t* wt_out = (bf16_t*)(p.ws + OFF_WT_OUT);
    bf16_t* wt_gu = (bf16_t*)(p.ws + OFF_WT_GU);
    bf16_t* wt_dn = (bf16_t*)(p.ws + OFF_WT_DN);
    for (int j = blockIdx.x; j < 2944; j += gridDim.x) {
        if (j < 576) { const int kt = j / 36, nt = j % 36; transpose_tile(p.w_in, INW, kt * 64, nt * 64, p.norm_mix, p.norm_mix, DM, wt_in, DM, 3, lds); }
        else if (j < 832) { const int jj = j - 576, kt = jj / 16, nt = jj % 16; transpose_tile(p.w_out, DM, kt * 64, nt * 64, p.out_norm_a, p.out_norm_b, 512, wt_out, DM, 0, lds); }
        else if (j < 1536) { const int jj = j - 832, kt = jj / 44, nt = jj % 44; transpose_tile(p.w_gate, DFF, kt * 64, nt * 64, p.norm_ffn, p.norm_ffn, DM, wt_gu, DM, 1, lds); }
        else if (j < 2240) { const int jj = j - 1536, kt = jj / 44, nt = jj % 44; transpose_tile(p.w_up, DFF, kt * 64, nt * 64, p.norm_ffn, p.norm_ffn, DM, wt_gu, DM, 2, lds); }
        else { const int jj = j - 2240, kt = jj / 16, nt = jj % 16; transpose_tile(p.w_down, DM, kt * 64, nt * 64, nullptr, nullptr, 0, wt_dn, DFF, 0, lds); }
    }
    bf16_t* xn = (bf16_t*)(p.ws + OFF_XN);
    const int lane = threadIdx.x & 63, w = threadIdx.x >> 6;
    for (int row = blockIdx.x * 8 + w; row < NTOK; row += gridDim.x * 8) {
        const f32x4* xr = (const f32x4*)(p.x + (size_t)row * DM);
        f32x4 v[4]; float ss = 0.f;
#pragma unroll
        for (int i = 0; i < 4; ++i) { v[i] = __builtin_nontemporal_load(xr + lane + 64 * i); ss += sq4(v[i]); }
        ss = wave_sum(ss);
        const float rs = rsqrtf(ss * (1.0f / DM) + EPS);
#pragma unroll
        for (int i = 0; i < 4; ++i) store4(xn + (size_t)row * DM + (lane + 64 * i) * 4, v[i] * rs);
    }
    if (blockIdx.x == 0 && threadIdx.x < 64) {
        float gq = fabsf(p.q_norm_a[threadIdx.x]), gk = fabsf(p.k_norm_a[threadIdx.x]);
#pragma unroll
        for (int o = 32; o >= 1; o >>= 1) { gq = fmaxf(gq, __shfl_xor(gq, o)); gk = fmaxf(gk, __shfl_xor(gk, o)); }
        if (threadIdx.x == 0) *(float*)(p.ws + OFF_MREF) = 8.0f * LOG2E * gq * gk * 1.02f + 0.1f;
    }
    const int gt = blockIdx.x * 512 + threadIdx.x;
    if (gt < 2048) {
        const int pos = gt >> 4, i = gt & 15;
        const float invf = __builtin_amdgcn_exp2f(-(float)i * 0.830482023721841f);
        const float ang = (float)pos * invf;
        double rev = (double)ang * 0.15915494309189535;
        rev -= __builtin_rint(rev);
        const float rv = (float)rev;
        f32x2 cs; cs.x = __builtin_amdgcn_cosf(rv); cs.y = __builtin_amdgcn_sinf(rv);
        ((f32x2*)(p.ws + OFF_ROPE))[gt] = cs;
    }
}

struct EpiQKV {
    static constexpr bool HAS_PREP = false, HAS_MID = false; static constexpr int MID_T = -1;
    const float *qg, *kg; unsigned char* ws;
    DI void prep(const Unit&, tab_t) const {}
    DI void mid(f32x4 (&)[2][2][4][2], tab_t, int, int) const {}
    DI void rope_heads(const f32x4 (&acc)[2][2][4][2], const float* __restrict__ gain, float scale, bf16_t* __restrict__ dst, int ldd, int row0, int fr, int fq) const {
        const f32x4* rope = (const f32x4*)(ws + OFF_ROPE);
        f32x4 g[2][2];
#pragma unroll
        for (int bj = 0; bj < 2; ++bj)
#pragma unroll
            for (int n = 0; n < 2; ++n) g[bj][n] = *(const f32x4*)(gain + 32 * bj + 16 * n + 4 * fq);
#pragma unroll
        for (int ai = 0; ai < 2; ++ai)
#pragma unroll
            for (int m = 0; m < 4; ++m) {
                const int t = row0 + ai * HALF + m * 16 + fr;
                float ss = (sq4(acc[ai][0][m][0]) + sq4(acc[ai][0][m][1])) + (sq4(acc[ai][1][m][0]) + sq4(acc[ai][1][m][1]));
                ss += __shfl_xor(ss, 16); ss += __shfl_xor(ss, 32);
                const float rs = rsqrtf(ss * (1.0f / 64.0f) + EPS);
                const int sidx = t & (SEQL - 1), row = sidx >> 6, col = sidx & 63;
                bf16_t* d = dst + (size_t)t * ldd + fq * 4;
#pragma unroll
                for (int bj = 0; bj < 2; ++bj) {
                    const int pos = bj == 0 ? row : col;
                    const f32x4 t0 = rope[(pos * 16 + fq * 4) >> 1], t1 = rope[((pos * 16 + fq * 4) >> 1) + 1];
                    const float c[4] = {t0[0], t0[2], t1[0], t1[2]}, sn[4] = {t0[1], t0[3], t1[1], t1[3]};
                    f32x4 o0, o1;
#pragma unroll
                    for (int j = 0; j < 4; ++j) {
                        const float x1 = acc[ai][bj][m][0][j] * rs * g[bj][0][j], x2 = acc[ai][bj][m][1][j] * rs * g[bj][1][j];
                        o0[j] = (x1 * c[j] - x2 * sn[j]) * scale; o1[j] = (x2 * c[j] + x1 * sn[j]) * scale;
                    }
                    store4(d + 32 * bj, o0); store4(d + 32 * bj + 16, o1);
                }
            }
    }
    DI void vt_heads(const f32x4 (&acc)[2][2][4][2], bf16_t* __restrict__ base, int dsel  , int row0, int wc, int fr, int fq, int hn = 0) const {
#pragma unroll
        for (int ai = 0; ai < 2; ++ai)
#pragma unroll
            for (int m = 0; m < 4; ++m) {
                const int t = row0 + ai * HALF + m * 16 + fr, b = t >> 13, sidx = t & (SEQL - 1);
#pragma unroll
                for (int bjr = 0; bjr < 2; ++bjr) {
                    if (hn != 0 && bjr == 1) continue;
                    const int bj = hn ? hn - 1 : bjr;
#pragma unroll
                    for (int n = 0; n < 2; ++n) {
                        bf16_t* dp = dsel == 0 ? base + ((size_t)(b * 2) * 64 + 32 * bj + 16 * n + 4 * fq) * SEQL + sidx
                                               : base + ((size_t)(b * 8 + 2 * bj + (wc >> 1)) * 64 + (wc & 1) * 32 + 16 * n + 4 * fq) * SEQL + sidx;
#pragma unroll
                        for (int j = 0; j < 4; ++j) store1(dp + (size_t)j * SEQL, acc[ai][bjr][m][n][j]);
                    }
                }
            }
    }
    DI void operator()(f32x4 (&acc)[2][2][4][2], const Unit& u, tab_t, int wr, int wc, int fr, int fq, LAS unsigned char*) const {
        const int pn = u.pn, row0 = u.pm * BM + wr * 64;
        if (pn <= 1) {
            rope_heads(acc, qg, QSCALE, (bf16_t*)(ws + OFF_QA) + (pn * 4 + wc) * 64, 512, row0, fr, fq);
        } else if (pn == 2) {
            if (wc < 2) rope_heads(acc, kg, 1.0f, (bf16_t*)(ws + OFF_KA) + wc * 64, 128, row0, fr, fq);
            else vt_heads(acc, (bf16_t*)(ws + OFF_VTA) + (size_t)(wc - 2) * 64 * SEQL, 0, row0, wc, fr, fq);
        } else if (pn <= 6) {
            const bool isq = pn <= 4;
            bf16_t* base = isq ? (bf16_t*)(ws + OFF_QB) + (pn - 3) * 256 : (bf16_t*)(ws + OFF_KB) + (pn - 5) * 256;
            const float sc = isq ? QSCALE : 1.0f;
#pragma unroll
            for (int ai = 0; ai < 2; ++ai)
#pragma unroll
                for (int m = 0; m < 4; ++m) {
                    bf16_t* d = base + (size_t)(row0 + ai * HALF + m * 16 + fr) * 512 + wc * 32 + fq * 8;
#pragma unroll
                    for (int bj = 0; bj < 2; ++bj) store8(d + bj * HALF, acc[ai][bj][m][0] * sc, acc[ai][bj][m][1] * sc);
                }
        } else {
            vt_heads(acc, (bf16_t*)(ws + OFF_VTB) + (size_t)(pn - 7) * 4 * 64 * SEQL, 1, row0, wc, fr, fq, u.hn);
        }
    }
};

DI void phase1(const Params& p, LAS unsigned char* lds) {
    QkvOrder S; S.init(gridDim.x, blockIdx.x);
    Gemm g{(const bf16_t*)(p.ws + OFF_XN), (const bf16_t*)(p.ws + OFF_WT_IN), DM};
    EpiQKV E{p.q_norm_a, p.k_norm_a, p.ws};
    gemm_phase<EpiQKV, QkvOrder>(lds, g, S, E);
}

constexpr int AT_NS = 8, AT_D = AT_NS - 1, AT_STG = 16384, AT_RPB = AT_NS * AT_STG;
DI float max3(float a, float b, float c) { return __builtin_fmaxf(__builtin_fmaxf(a, b), c); }
template <bool NAT, bool STATIC>
DI void attn_unit(const Params& p, int unit, LAS unsigned char* lds) {
    const int tid = threadIdx.x, lane = tid & 63, w = __builtin_amdgcn_readfirstlane(tid >> 6), r = lane & 31, h = lane >> 5;
    const int b = unit >> 8, rem = unit & 255;
    int head, t0, ldk, key0, ntiles, ocol, hslot;
    const bf16_t *Qp, *Kp, *Vtp;
    int rw = 0, rsw = 0, krow0 = 0;
    if (!NAT) {
        const int xcd = rem & 7, rest = rem >> 3, kvh = xcd & 1, idx = (xcd >> 1) + 4 * rest, hq = idx >> 5, qb = idx & 31;
        head = kvh * 4 + hq; t0 = b * SEQL + qb * 256;
        Qp = (const bf16_t*)(p.ws + OFF_QA) + (size_t)t0 * 512 + head * 64;
        Kp = (const bf16_t*)(p.ws + OFF_KA) + (size_t)b * SEQL * 128 + kvh * 64; ldk = 128;
        Vtp = (const bf16_t*)(p.ws + OFF_VTA) + (size_t)(b * 2 + kvh) * 64 * SEQL;
        key0 = 0; ntiles = 128; ocol = head * 64; hslot = head;
    } else {
        head = rem & 7; const int rq = rem >> 3; t0 = b * SEQL + rq * 256;
        Qp = (const bf16_t*)(p.ws + OFF_QB) + (size_t)t0 * 512 + head * 64;
        Kp = (const bf16_t*)(p.ws + OFF_KB) + (size_t)b * SEQL * 512 + head * 64; ldk = 512;
        Vtp = (const bf16_t*)(p.ws + OFF_VTB) + (size_t)(b * 8 + head) * 64 * SEQL;
        const int r0 = 4 * rq, rsA = min(max(r0 - 4, 0), 120), rsB = min(max(r0 - 1, 0), 120);
        krow0 = rsA; key0 = rsA * 64; ntiles = rsB + 8 - rsA; ocol = 512 + head * 64; hslot = 8 + head;
        rw = r0 + (w >> 1); rsw = min(max(rw - 4, 0), 120);
    }
    bf16x8 qf[4];
#pragma unroll
    for (int ks = 0; ks < 4; ++ks) qf[ks] = *(const bf16x8*)(Qp + (size_t)(w * 32 + r) * 512 + ks * 16 + h * 8);
    asm volatile("s_waitcnt vmcnt(0)" ::: "memory");
    __syncthreads();
    if (NAT) {
        LAS float* rl = (LAS float*)(lds + AT_RPB);
        if (tid < 465) rl[tid] = p.rpb[head * 465 + tid] * LOG2E;
        if (tid == 465) rl[465] = -1e30f;
        asm volatile("s_waitcnt vmcnt(0)" ::: "memory");
    }
    const int srow = tid >> 3, slc = (tid & 7) ^ ((srow >> 1) & 7);
    const bf16_t* kg = Kp + (size_t)(key0 + srow) * ldk + slc * 8;
    const bf16_t* vg = Vtp + (size_t)srow * SEQL + key0 + slc * 8;
    const unsigned ldsw = (unsigned)w * 1024u;
#define ISSUE_TILE(tt) do { const int _t = min((tt), ntiles - 1); const int _s = (tt) & (AT_NS - 1); \
        __builtin_amdgcn_global_load_lds((const unsigned*)(kg + (size_t)_t * 64 * ldk), (LAS unsigned*)(lds + _s * AT_STG + ldsw), 16, 0, 0); \
        __builtin_amdgcn_global_load_lds((const unsigned*)(vg + _t * 64), (LAS unsigned*)(lds + _s * AT_STG + 8192 + ldsw), 16, 0, 0); } while (0)
#pragma unroll
    for (int i = 0; i < AT_D - 1; ++i) ISSUE_TILE(i);
    f32x16 o0, o1, cinit;
#pragma unroll
    for (int i = 0; i < 16; ++i) { o0[i] = 0.f; o1[i] = 0.f; cinit[i] = 0.f; }
    float lsum = 0.f;
    bool first = true;
    const int pir = (r & 0x13) | ((r & 4) << 1) | ((r & 8) >> 1);
    int kofs[4], vofs[4];
#pragma unroll
    for (int i = 0; i < 4; ++i) {
        kofs[i] = pir * 128 + (((i * 2 + h) ^ ((pir >> 1) & 7)) << 4);
        vofs[i] = 8192 + r * 128 + (((i * 2 + h) ^ ((r >> 1) & 7)) << 4);
    }
    const int qc = (w & 1) * 32 + r, cs = min(max(qc - 8, 0), 48);
    constexpr float THR = 8.0f;
#define TILE_ACTIVE(t) (!NAT || ((krow0 + (t)) >= rsw && (krow0 + (t)) < rsw + 8))
#define FENCE __builtin_amdgcn_sched_barrier(0x407)
#define QK_TILE(tt, d0, d1) do { LAS unsigned char* _sb = lds + ((tt) & (AT_NS - 1)) * AT_STG; \
        bf16x8 ka0 = *(const LAS bf16x8*)(_sb + kofs[0]), ka1 = *(const LAS bf16x8*)(_sb + kofs[0] + 4096); \
        bf16x8 kb0 = *(const LAS bf16x8*)(_sb + kofs[1]), kb1 = *(const LAS bf16x8*)(_sb + kofs[1] + 4096); \
        FENCE; __builtin_amdgcn_s_setprio(2); \
        d0 = __builtin_amdgcn_mfma_f32_32x32x16_bf16(ka0, qf[0], cinit, 0, 0, 0); d1 = __builtin_amdgcn_mfma_f32_32x32x16_bf16(ka1, qf[0], cinit, 0, 0, 0); \
        ka0 = *(const LAS bf16x8*)(_sb + kofs[2]); ka1 = *(const LAS bf16x8*)(_sb + kofs[2] + 4096); \
        FENCE; \
        d0 = __builtin_amdgcn_mfma_f32_32x32x16_bf16(kb0, qf[1], d0, 0, 0, 0); d1 = __builtin_amdgcn_mfma_f32_32x32x16_bf16(kb1, qf[1], d1, 0, 0, 0); \
        kb0 = *(const LAS bf16x8*)(_sb + kofs[3]); kb1 = *(const LAS bf16x8*)(_sb + kofs[3] + 4096); \
        FENCE; \
        d0 = __builtin_amdgcn_mfma_f32_32x32x16_bf16(ka0, qf[2], d0, 0, 0, 0); d1 = __builtin_amdgcn_mfma_f32_32x32x16_bf16(ka1, qf[2], d1, 0, 0, 0); \
        FENCE; \
        d0 = __builtin_amdgcn_mfma_f32_32x32x16_bf16(kb0, qf[3], d0, 0, 0, 0); d1 = __builtin_amdgcn_mfma_f32_32x32x16_bf16(kb1, qf[3], d1, 0, 0, 0); \
        __builtin_amdgcn_s_setprio(0); FENCE; } while (0)
#define STEP(T, A0, A1, B0, B1, MODE) do { \
        if (((T) + 1 < ntiles) && TILE_ACTIVE((T) + 1)) QK_TILE((T) + 1, B0, B1); \
        if (TILE_ACTIVE(T)) { \
            LAS unsigned char* sb = lds + ((T) & (AT_NS - 1)) * AT_STG; \
            if (NAT) { \
                const int dr = krow0 + (T) - rw + 7; \
                const LAS float* rl = (const LAS float*)(lds + AT_RPB); \
                const int ib = dr * 31 - qc + 15; \
                _Pragma("unroll") for (int g = 0; g < 16; ++g) { \
                    const int kc0 = 16 * (g >> 3) + 8 * h + (g & 7), kc1 = kc0 + 32; \
                    const int i0 = ((unsigned)(kc0 - cs) < 16u) ? ib + kc0 : 465, i1 = ((unsigned)(kc1 - cs) < 16u) ? ib + kc1 : 465; \
                    A0[g] += rl[i0]; A1[g] += rl[i1]; \
                } \
            } \
            if ((MODE) != 2) { \
            float mx = max3(A0[0], A1[0], A0[1]); \
            mx = max3(mx, A1[1], A0[2]); \
            _Pragma("unroll") for (int i = 2; i < 15; ++i) mx = max3(mx, A1[i], A0[i + 1]); \
            mx = fmaxf(mx, A1[15]); \
            { auto sw = __builtin_amdgcn_permlane32_swap(__float_as_uint(mx), __float_as_uint(mx), false, false); \
              mx = fmaxf(__uint_as_float(sw[0]), __uint_as_float(sw[1])); } \
            if (first || __builtin_amdgcn_ballot_w64(mx > THR) != 0ull) {            \
                asm volatile("" ::: "memory");                                        \
                const float delta = (first || mx > THR) ? mx : 0.f; \
                const float alpha = __builtin_amdgcn_exp2f(-delta); \
                lsum *= alpha; \
                _Pragma("unroll") for (int i = 0; i < 16; ++i) { o0[i] *= alpha; o1[i] *= alpha; A0[i] -= delta; A1[i] -= delta; B0[i] -= delta; B1[i] -= delta; cinit[i] -= delta; } \
                first = false; \
            } \
            } \
            bf16x8 va0 = *(const LAS bf16x8*)(sb + vofs[0]), va1 = *(const LAS bf16x8*)(sb + vofs[0] + 4096); \
            bf16x8 vb0 = *(const LAS bf16x8*)(sb + vofs[1]), vb1 = *(const LAS bf16x8*)(sb + vofs[1] + 4096); \
            FENCE; __builtin_amdgcn_s_setprio(1); \
            float ps = 0.f; \
            _Pragma("unroll") for (int i = 0; i < 16; ++i) { A0[i] = __builtin_amdgcn_exp2f(A0[i]); A1[i] = __builtin_amdgcn_exp2f(A1[i]); ps += A0[i]; ps += A1[i]; } \
            lsum += ps; \
            u32x4 pw; bf16x8 pf; \
            pw.x = pack2(A0[0], A0[1]); pw.y = pack2(A0[2], A0[3]); pw.z = pack2(A0[4], A0[5]); pw.w = pack2(A0[6], A0[7]); pf = __builtin_bit_cast(bf16x8, pw); \
            o0 = __builtin_amdgcn_mfma_f32_32x32x16_bf16(va0, pf, o0, 0, 0, 0); o1 = __builtin_amdgcn_mfma_f32_32x32x16_bf16(va1, pf, o1, 0, 0, 0); \
            va0 = *(const LAS bf16x8*)(sb + vofs[2]); va1 = *(const LAS bf16x8*)(sb + vofs[2] + 4096); \
            FENCE; \
            pw.x = pack2(A0[8], A0[9]); pw.y = pack2(A0[10], A0[11]); pw.z = pack2(A0[12], A0[13]); pw.w = pack2(A0[14], A0[15]); pf = __builtin_bit_cast(bf16x8, pw); \
            o0 = __builtin_amdgcn_mfma_f32_32x32x16_bf16(vb0, pf, o0, 0, 0, 0); o1 = __builtin_amdgcn_mfma_f32_32x32x16_bf16(vb1, pf, o1, 0, 0, 0); \
            vb0 = *(const LAS bf16x8*)(sb + vofs[3]); vb1 = *(const LAS bf16x8*)(sb + vofs[3] + 4096); \
            FENCE; \
            pw.x = pack2(A1[0], A1[1]); pw.y = pack2(A1[2], A1[3]); pw.z = pack2(A1[4], A1[5]); pw.w = pack2(A1[6], A1[7]); pf = __builtin_bit_cast(bf16x8, pw); \
            o0 = __builtin_amdgcn_mfma_f32_32x32x16_bf16(va0, pf, o0, 0, 0, 0); o1 = __builtin_amdgcn_mfma_f32_32x32x16_bf16(va1, pf, o1, 0, 0, 0); \
            FENCE; \
            pw.x = pack2(A1[8], A1[9]); pw.y = pack2(A1[10], A1[11]); pw.z = pack2(A1[12], A1[13]); pw.w = pack2(A1[14], A1[15]); pf = __builtin_bit_cast(bf16x8, pw); \
            o0 = __builtin_amdgcn_mfma_f32_32x32x16_bf16(vb0, pf, o0, 0, 0, 0); o1 = __builtin_amdgcn_mfma_f32_32x32x16_bf16(vb1, pf, o1, 0, 0, 0); \
            __builtin_amdgcn_s_setprio(0); FENCE; \
        } } while (0)
    asm volatile("s_waitcnt vmcnt(10) lgkmcnt(0)" ::: "memory");
    BAR;
    if (STATIC) {
        const float mref = *(const float*)(p.ws + OFF_MREF);
#pragma unroll
        for (int i = 0; i < 16; ++i) cinit[i] = -mref;
        first = false;
    }
    f32x16 s0, s1, n0, n1;
    if (TILE_ACTIVE(0)) QK_TILE(0, s0, s1);
    for (int t = 0; t < ntiles; t += 2) {
        asm volatile("s_waitcnt vmcnt(6) lgkmcnt(0)" ::: "memory");
        BAR;
        ISSUE_TILE(t + 6); ISSUE_TILE(t + 7);
        STEP(t, s0, s1, n0, n1, (STATIC ? 2 : 0)); if (t + 1 < ntiles) STEP(t + 1, n0, n1, s0, s1, (STATIC ? 2 : 0));
    }
#undef STEP
#undef ISSUE_TILE
#undef TILE_ACTIVE
#undef QK_TILE
#undef FENCE
    { auto sw = __builtin_amdgcn_permlane32_swap(__float_as_uint(lsum), __float_as_uint(lsum), false, false);
      lsum = __uint_as_float(sw[0]) + __uint_as_float(sw[1]); }
    const float linv = 1.0f / lsum;
    const int tok = t0 + w * 32 + r;
    bf16_t* od = (bf16_t*)(p.ws + OFF_OMIX) + (size_t)tok * DM + ocol + 4 * h;
    float ss = 0.f;
#pragma unroll
    for (int gq = 0; gq < 4; ++gq) {
        f32x4 a = {o0[gq * 4] * linv, o0[gq * 4 + 1] * linv, o0[gq * 4 + 2] * linv, o0[gq * 4 + 3] * linv};
        f32x4 c = {o1[gq * 4] * linv, o1[gq * 4 + 1] * linv, o1[gq * 4 + 2] * linv, o1[gq * 4 + 3] * linv};
        ss += sq4(a) + sq4(c);
        store4(od + 8 * gq, a); store4(od + 32 + 8 * gq, c);
    }
    ss += __shfl_xor(ss, 32);
    if (h == 0) ((float*)(p.ws + OFF_SSO))[(size_t)tok * 16 + hslot] = ss;
}

DI void phase2(const Params& p, LAS unsigned char* lds) {
    const bool use_static = *(const float*)(p.ws + OFF_MREF) <= 40.0f;
    for (int u = blockIdx.x; u < 2048; u += gridDim.x) {
        if (u < 1024) { if (use_static) attn_unit<false, true>(p, u, lds); else attn_unit<false, false>(p, u, lds); }
        else attn_unit<true, false>(p, u - 1024, lds);
    }
}

struct EpiOut {
    static constexpr bool HAS_PREP = true, HAS_MID = true; static constexpr int MID_T = 8;
    const float* x; float* out; unsigned char* ws;
    DI void prep(const Unit& u, tab_t tab) const {
        const int tid = threadIdx.x;
        if (tid < 256) {
            const f32x4* s = (const f32x4*)((const float*)(ws + OFF_SSO) + (size_t)(u.pm * BM + tid) * 16);
            const float sa = sum4(s[0]) + sum4(s[1]), sb = sum4(s[2]) + sum4(s[3]);
            const float ra = rsqrtf(sa * (1.0f / 512.0f) + EPS), rb = rsqrtf(sb * (1.0f / 512.0f) + EPS);
            tab[tid] = (f32x2){ra / rb, rb};
        }
    }
    DI void mid(f32x4 (&acc)[2][2][4][2], tab_t tab, int wr, int fr) const {
#pragma unroll
        for (int ai = 0; ai < 2; ++ai)
#pragma unroll
            for (int m = 0; m < 4; ++m) {
                const float rt = tab[ai * HALF + wr * 64 + m * 16 + fr].x;
#pragma unroll
                for (int bj = 0; bj < 2; ++bj)
#pragma unroll
                    for (int n = 0; n < 2; ++n) acc[ai][bj][m][n] *= rt;
            }
    }
    DI void operator()(f32x4 (&acc)[2][2][4][2], const Unit& u, tab_t tab, int wr, int wc, int fr, int fq, LAS unsigned char*) const {
        bf16_t* x1b = (bf16_t*)(ws + OFF_X1B);
        float* ss2 = (float*)(ws + OFF_SS2);
#pragma unroll
        for (int ai = 0; ai < 2; ++ai) {
            f32x4 xv[4][2][2];
#pragma unroll
            for (int m = 0; m < 4; ++m) {
                const size_t off = (size_t)(u.pm * BM + ai * HALF + wr * 64 + m * 16 + fr) * DM + u.pn * BM + wc * 32 + fq * 8;
#pragma unroll
                for (int bj = 0; bj < 2; ++bj)
#pragma unroll
                    for (int n = 0; n < 2; ++n) xv[m][bj][n] = *(const f32x4*)(x + off + bj * HALF + n * 4);
            }
#pragma unroll
            for (int m = 0; m < 4; ++m) {
                const int rl = ai * HALF + wr * 64 + m * 16 + fr, t = u.pm * BM + rl;
                const float rb = tab[rl].y;
                const size_t off = (size_t)t * DM + u.pn * BM + wc * 32 + fq * 8;
                float ss = 0.f;
#pragma unroll
                for (int bj = 0; bj < 2; ++bj) {
                    const f32x4 v0 = xv[m][bj][0] + acc[ai][bj][m][0] * rb, v1 = xv[m][bj][1] + acc[ai][bj][m][1] * rb;
                    ss += sq4(v0) + sq4(v1);
                    store8(x1b + off + bj * HALF, v0, v1);
                }
                ss += __shfl_xor(ss, 16); ss += __shfl_xor(ss, 32);
                if (fq == 0) ss2[(size_t)t * 16 + u.pn * 4 + wc] = ss;
            }
            asm volatile("" ::: "memory");
        }
    }
};
DI void phase3(const Params& p, LAS unsigned char* lds) {
    StaticOrder S; S.init(NTOK, DM, gridDim.x, blockIdx.x);
    Gemm g{(const bf16_t*)(p.ws + OFF_OMIX), (const bf16_t*)(p.ws + OFF_WT_OUT), DM};
    EpiOut E{p.x, p.out, p.ws};
    gemm_phase<EpiOut, StaticOrder>(lds, g, S, E);
}

struct EpiGU {
    static constexpr bool HAS_PREP = true, HAS_MID = false; static constexpr int MID_T = -1;
    unsigned char* ws;
    DI void prep(const Unit& u, tab_t tab) const {
        const int tid = threadIdx.x;
        if (tid < 256) {
            const f32x4* s = (const f32x4*)((const float*)(ws + OFF_SS2) + (size_t)(u.pm * BM + tid) * 16);
            const float sa = (sum4(s[0]) + sum4(s[1])) + (sum4(s[2]) + sum4(s[3]));
            tab[tid] = (f32x2){rsqrtf(sa * (1.0f / DM) + EPS), 0.f};
        }
    }
    DI void mid(f32x4 (&)[2][2][4][2], tab_t, int, int) const {}
    DI void operator()(f32x4 (&acc)[2][2][4][2], const Unit& u, tab_t tab, int wr, int wc, int fr, int fq, LAS unsigned char*) const {
        bf16_t* hbuf = (bf16_t*)(ws + OFF_H);
#pragma unroll
        for (int ai = 0; ai < 2; ++ai)
#pragma unroll
            for (int m = 0; m < 4; ++m) {
                const int rl = ai * HALF + wr * 64 + m * 16 + fr;
                const float rs = tab[rl].x;
                bf16_t* d = hbuf + (size_t)(u.pm * BM + rl) * DFF + u.pn * 128 + wc * 32 + fq * 8;
                f32x4 o[2];
#pragma unroll
                for (int n = 0; n < 2; ++n) {
#pragma unroll
                    for (int j = 0; j < 4; ++j) {
                        const float g = acc[ai][0][m][n][j] * rs, uu = acc[ai][1][m][n][j] * rs;
                        o[n][j] = g * uu * __builtin_amdgcn_rcpf(1.0f + __builtin_amdgcn_exp2f(-g * LOG2E));
                    }
                }
                store8(d, o[0], o[1]);
            }
    }
};
DI void phase4(const Params& p, LAS unsigned char* lds) {
    StaticOrder S; S.init(NTOK, 2 * DFF, gridDim.x, blockIdx.x);
    Gemm g{(const bf16_t*)(p.ws + OFF_X1B), (const bf16_t*)(p.ws + OFF_WT_GU), DM};
    EpiGU E{p.ws};
    gemm_phase<EpiGU, StaticOrder>(lds, g, S, E);
}

struct EpiDown {
    static constexpr bool HAS_PREP = false, HAS_MID = false; static constexpr int MID_T = -1;
    float* out; unsigned char* ws; const float* gfin;
    DI void prep(const Unit&, tab_t) const {}
    DI void mid(f32x4 (&)[2][2][4][2], tab_t, int, int) const {}
    DI void operator()(f32x4 (&acc)[2][2][4][2], const Unit& u, tab_t, int wr, int wc, int fr, int fq, LAS unsigned char* lds) const {
        const bf16_t* x1b = (const bf16_t*)(ws + OFF_X1B);
        float* xbuf = (float*)(ws + OFF_XBUF);
        unsigned* cnt = (unsigned*)(ws + OFF_PCNT) + 64 * u.pm;
        LAS float* P = (LAS float*)(lds + TAB_OFF);
        LAS float* S = (LAS float*)(lds + TAB_OFF + 4096);
        const int tid = threadIdx.x;
#pragma unroll
        for (int ai = 0; ai < 2; ++ai) {
            u32x4 xv[4][2];
#pragma unroll
            for (int m = 0; m < 4; ++m) {
                const size_t off = (size_t)(u.pm * BM + ai * HALF + wr * 64 + m * 16 + fr) * DM + u.pn * BM + wc * 32 + fq * 8;
#pragma unroll
                for (int bj = 0; bj < 2; ++bj) xv[m][bj] = *(const u32x4*)(x1b + off + bj * HALF);
            }
#pragma unroll
            for (int m = 0; m < 4; ++m) {
                float ss = 0.f;
#pragma unroll
                for (int bj = 0; bj < 2; ++bj) {
                    const u32x4 w = xv[m][bj];
                    const f32x4 x0 = {__uint_as_float(w.x << 16), __uint_as_float(w.x & 0xffff0000u), __uint_as_float(w.y << 16), __uint_as_float(w.y & 0xffff0000u)};
                    const f32x4 x1 = {__uint_as_float(w.z << 16), __uint_as_float(w.z & 0xffff0000u), __uint_as_float(w.w << 16), __uint_as_float(w.w & 0xffff0000u)};
                    acc[ai][bj][m][0] += x0; acc[ai][bj][m][1] += x1;
                    ss += sq4(acc[ai][bj][m][0]) + sq4(acc[ai][bj][m][1]);
                }
                ss += __shfl_xor(ss, 16); ss += __shfl_xor(ss, 32);
                if (fq == 0) P[(ai * HALF + wr * 64 + m * 16 + fr) * 4 + wc] = ss;
            }
            asm volatile("" ::: "memory");
        }
        asm volatile("s_waitcnt lgkmcnt(0)" ::: "memory"); BAR; asm volatile("" ::: "memory");
        if (tid < 256) {
            const f32x4 pp = *(const LAS f32x4*)(P + tid * 4);
            __hip_atomic_store(xbuf + (size_t)(u.pm * BM + tid) * 4 + u.pn, (pp[0] + pp[1]) + (pp[2] + pp[3]), __ATOMIC_RELAXED, __HIP_MEMORY_SCOPE_AGENT);
            asm volatile("s_waitcnt vmcnt(0)" ::: "memory");
            if ((tid & 63) == 0) __hip_atomic_fetch_add(cnt, 1u, __ATOMIC_RELAXED, __HIP_MEMORY_SCOPE_AGENT);
        }
        if (tid < 64) {
            for (unsigned it = 0; (unsigned)__builtin_amdgcn_readfirstlane((int)__hip_atomic_load(cnt, __ATOMIC_RELAXED, __HIP_MEMORY_SCOPE_AGENT)) < 16u && it < (1u << 22); ++it) __builtin_amdgcn_s_sleep(2);
            __builtin_amdgcn_fence(__ATOMIC_ACQUIRE, "agent");
            asm volatile("s_waitcnt vmcnt(0)" ::: "memory");
        }
        asm volatile("s_waitcnt vmcnt(0) lgkmcnt(0)" ::: "memory"); BAR; asm volatile("" ::: "memory");
        if (tid < 256) {
            const unsigned long long* slot = (const unsigned long long*)(xbuf + (size_t)(u.pm * BM + tid) * 4);
            const unsigned long long w0 = __hip_atomic_load(slot, __ATOMIC_RELAXED, __HIP_MEMORY_SCOPE_AGENT), w1 = __hip_atomic_load(slot + 1, __ATOMIC_RELAXED, __HIP_MEMORY_SCOPE_AGENT);
            const float q = (__uint_as_float((unsigned)w0) + __uint_as_float((unsigned)(w0 >> 32))) + (__uint_as_float((unsigned)w1) + __uint_as_float((unsigned)(w1 >> 32)));
            S[tid] = rsqrtf(q * (1.0f / DM) + EPS);
        }
        asm volatile("s_waitcnt lgkmcnt(0)" ::: "memory"); BAR; asm volatile("" ::: "memory");
        f32x4 gv[2][2];
#pragma unroll
        for (int bj = 0; bj < 2; ++bj)
#pragma unroll
            for (int n = 0; n < 2; ++n) gv[bj][n] = *(const f32x4*)(gfin + u.pn * BM + bj * HALF + wc * 32 + fq * 8 + n * 4);
#pragma unroll
        for (int ai = 0; ai < 2; ++ai)
#pragma unroll
            for (int m = 0; m < 4; ++m) {
                const int rl = ai * HALF + wr * 64 + m * 16 + fr;
                const float rs = S[rl];
                float* o = out + (size_t)(u.pm * BM + rl) * DM + u.pn * BM + wc * 32 + fq * 8;
#pragma unroll
                for (int bj = 0; bj < 2; ++bj) {
                    *(f32x4*)(o + bj * HALF) = acc[ai][bj][m][0] * rs * gv[bj][0];
                    *(f32x4*)(o + bj * HALF + 4) = acc[ai][bj][m][1] * rs * gv[bj][1];
                }
            }
    }
};
DI void phase5(const Params& p, LAS unsigned char* lds) {
    StaticOrder S; S.init(NTOK, DM, gridDim.x, blockIdx.x);
    Gemm g{(const bf16_t*)(p.ws + OFF_H), (const bf16_t*)(p.ws + OFF_WT_DN), DFF};
    EpiDown E{p.out, p.ws, p.norm_final};
    gemm_phase<EpiDown, StaticOrder>(lds, g, S, E);
}

#define XB_TMO      128
#define XB_XCNT(j)  (256  + 64 * (j))
#define XB_XSUB(j)  (1280 + 64 * (j))
#define XB_XGEN(j)  (2304 + 64 * (j))
#define XB_TOP      3328
#define XB_TOPGEN   3392
#define XCD_BAR_WORDS 3456
#define XB_SPIN_CAP (1u << 20)
DI unsigned xb_ld(unsigned* p)              { return __hip_atomic_load(p, __ATOMIC_RELAXED, __HIP_MEMORY_SCOPE_AGENT); }
DI unsigned xb_add(unsigned* p, unsigned v) { return __hip_atomic_fetch_add(p, v, __ATOMIC_RELAXED, __HIP_MEMORY_SCOPE_AGENT); }
DI unsigned xb_xcc_id() { return (unsigned)__builtin_amdgcn_s_getreg((3 << 11) | 20) & 0xFu; }
#define XB_SPIN(cond, bar) do { unsigned _sp = 0; while (cond) { __builtin_amdgcn_s_sleep(1); \
    if ((++_sp & 255u) == 0u) { if (xb_ld(&(bar)[XB_TMO])) break; if (_sp > XB_SPIN_CAP) { xb_add(&(bar)[XB_TMO], 1u); break; } } } } while (0)
struct XcdBarrier { unsigned* bar; unsigned x; volatile LAS unsigned* st; };
DI XcdBarrier xcd_barrier_post(unsigned* bar, volatile LAS unsigned* st) {
    XcdBarrier b; b.bar = bar; b.x = xb_xcc_id(); b.st = st;
    if (threadIdx.x == 0) (void)xb_add(&bar[XB_XCNT(b.x)], 1u);
    return b;
}
DI void xcd_barrier_complete(unsigned* bar, unsigned x, unsigned& nloc, unsigned& nx) {
    const unsigned G = gridDim.x;
    unsigned sum, cnt, mine, sp = 0u;
    for (;;) {
        sum = 0u; cnt = 0u; mine = 0u;
#pragma unroll
        for (unsigned j = 0; j < 16; ++j) { const unsigned c = xb_ld(&bar[XB_XCNT(j)]); sum += c; cnt += (c > 0u) ? 1u : 0u; mine = (j == x) ? c : mine; }
        if (sum == G) break;
        __builtin_amdgcn_s_sleep(1);
        if ((++sp & 255u) == 0u) { if (xb_ld(&bar[XB_TMO])) break; if (sp > XB_SPIN_CAP) { xb_add(&bar[XB_TMO], 1u); break; } }
    }
    nloc = mine > 0u ? mine : 1u; nx = cnt > 0u ? cnt : 1u;
}
DI void grid_barrier(const XcdBarrier& b) {
    asm volatile("s_waitcnt vmcnt(0) lgkmcnt(0)" ::: "memory");
    __syncthreads();
    if (threadIdx.x == 0) {
        unsigned* bar = b.bar;
        unsigned nloc = b.st[0], nx = b.st[1];
        if (nloc == 0u) { xcd_barrier_complete(bar, b.x, nloc, nx); b.st[0] = nloc; b.st[1] = nx; }
        const unsigned old = xb_add(&bar[XB_XSUB(b.x)], 1u);
        const unsigned gen = old / nloc;
        if (old + 1u == (gen + 1u) * nloc) {
            __builtin_amdgcn_fence(__ATOMIC_RELEASE, "agent");
            asm volatile("s_waitcnt vmcnt(0)" ::: "memory");
            const unsigned og = xb_add(&bar[XB_TOP], 1u);
            const unsigned tg = og / nx;
            if (og + 1u == (tg + 1u) * nx) xb_add(&bar[XB_TOPGEN], 1u);
            else XB_SPIN(xb_ld(&bar[XB_TOPGEN]) == tg, bar);
            __builtin_amdgcn_fence(__ATOMIC_ACQUIRE, "agent");
            xb_add(&bar[XB_XGEN(b.x)], 1u);
            asm volatile("s_waitcnt vmcnt(0)" ::: "memory");
        } else {
            XB_SPIN(xb_ld(&bar[XB_XGEN(b.x)]) == gen, bar);
            __builtin_amdgcn_fence(__ATOMIC_ACQUIRE, "agent");
            asm volatile("s_waitcnt vmcnt(0)" ::: "memory");
        }
    }
    __syncthreads();
}

constexpr int LDS_BYTES = STAGE_BYTES + 8192;
__global__ void __launch_bounds__(512, 2) mega(Params p, int ph_lo, int ph_hi) {
    extern __shared__ __attribute__((aligned(16))) unsigned char lds_raw[];
    LAS unsigned char* lds = (LAS unsigned char*)lds_raw;
    volatile LAS unsigned* xst = (volatile LAS unsigned*)(lds + TAB_OFF + 8176);
    if (threadIdx.x == 0) { xst[0] = 0u; xst[1] = 0u; }
    __syncthreads();
    const XcdBarrier xb = xcd_barrier_post((unsigned*)(p.ws + OFF_BAR), xst);
    if (ph_lo < 0) cg::this_grid().sync();
#define PHASE(n, call) if (ph_lo <= (n) && (n) < ph_hi) { call; if ((n) + 1 < ph_hi) grid_barrier(xb); }
    PHASE(0, phase0(p, lds))
    PHASE(1, phase1(p, lds))
    PHASE(2, phase2(p, lds))
#ifdef PROBE_DUP2
    PHASE(2, phase2(p, lds))
#endif
    PHASE(3, phase3(p, lds))
#ifdef PROBE_DUP3
    PHASE(3, phase3(p, lds))
#endif
    PHASE(4, phase4(p, lds))
#ifdef PROBE_DUP4
    PHASE(4, phase4(p, lds))
#endif
    PHASE(5, phase5(p, lds))
#undef PHASE
}

extern "C" void kernel_launch(void* const* d_in, const int* in_sizes, int n_in, void* d_out, int out_size, void* d_ws, size_t ws_size,
                              hipStream_t stream) {
    static int grid_blocks = 0;
    if (!grid_blocks) {
        int dev = 0, cus = 0, per_cu = 0;
        (void)hipGetDevice(&dev);
        (void)hipDeviceGetAttribute(&cus, hipDeviceAttributeMultiprocessorCount, dev);
        (void)hipFuncSetAttribute((const void*)mega, hipFuncAttributeMaxDynamicSharedMemorySize, LDS_BYTES);
        (void)hipOccupancyMaxActiveBlocksPerMultiprocessor(&per_cu, (const void*)mega, 512, LDS_BYTES);
        if (per_cu < 1) per_cu = 1;
        if (per_cu > 1) per_cu = 1;
        grid_blocks = cus * per_cu;
    }
    Params p{};
    p.x = (const float*)d_in[0]; p.norm_mix = (const float*)d_in[1]; p.w_in = (const float*)d_in[2]; p.q_norm_a = (const float*)d_in[3];
    p.k_norm_a = (const float*)d_in[4]; p.rpb = (const float*)d_in[5]; p.out_norm_a = (const float*)d_in[6]; p.out_norm_b = (const float*)d_in[7];
    p.w_out = (const float*)d_in[8]; p.norm_ffn = (const float*)d_in[9]; p.w_gate = (const float*)d_in[10]; p.w_up = (const float*)d_in[11];
    p.w_down = (const float*)d_in[12]; p.norm_final = (const float*)d_in[13];
    p.out = (float*)d_out; p.ws = (unsigned char*)d_ws;
    int lo = 0, hi = 6;
    void* args[] = {&p, &lo, &hi};
    (void)hipMemsetAsync((unsigned char*)d_ws + OFF_BAR, 0, 16384 + 128 * 256, stream);
    hipError_t e = hipLaunchCooperativeKernel((const void*)mega, dim3(grid_blocks), dim3(512), args, LDS_BYTES, stream);
    if (e != hipSuccess) fprintf(stderr, "cooperative launch failed: %s (grid %d)\n", hipGetErrorString(e), grid_blocks);
}
```

```cpp
#include <hip/hip_runtime.h>
#include <hip/hip_cooperative_groups.h>
#include <cstdio>
#include <cstdint>
namespace cg = cooperative_groups;

#define LAS __attribute__((address_space(3)))
#define DI __device__ __forceinline__
typedef unsigned short bf16_t;
typedef short bf16x8 __attribute__((ext_vector_type(8)));
typedef float f32x4 __attribute__((ext_vector_type(4)));
typedef float f32x2 __attribute__((ext_vector_type(2)));
typedef float f32x16 __attribute__((ext_vector_type(16)));
typedef unsigned u32x4 __attribute__((ext_vector_type(4)));
typedef unsigned u32x2 __attribute__((ext_vector_type(2)));

constexpr int NTOK = 32768, DM = 1024, SEQL = 8192, INW = 2304, DFF = 2816;
constexpr float EPS = 1e-6f;
constexpr float LOG2E = 1.4426950408889634f;
constexpr float QSCALE = 0.125f * LOG2E;

constexpr size_t OFF_WT_IN = 0;
constexpr size_t OFF_WT_OUT = OFF_WT_IN + (size_t)INW * DM * 2;
constexpr size_t OFF_WT_GU = OFF_WT_OUT + (size_t)DM * DM * 2;
constexpr size_t OFF_WT_DN = OFF_WT_GU + (size_t)2 * DFF * DM * 2;
constexpr size_t OFF_ROPE = OFF_WT_DN + (size_t)DM * DFF * 2;
constexpr size_t OFF_SSO = OFF_ROPE + 128 * 16 * 8;
constexpr size_t OFF_SS2 = OFF_SSO + (size_t)NTOK * 16 * 4;
constexpr size_t OFF_SS3 = OFF_SS2 + (size_t)NTOK * 16 * 4;
constexpr size_t OFF_OMIX = OFF_SS3 + (size_t)NTOK * 16 * 4;
constexpr size_t OFF_X1B = OFF_OMIX + (size_t)NTOK * DM * 2;
constexpr size_t OFF_XN = OFF_X1B + (size_t)NTOK * DM * 2;
constexpr size_t OFF_QA = OFF_XN + (size_t)NTOK * DM * 2;
constexpr size_t OFF_KA = OFF_QA + (size_t)NTOK * 512 * 2;
constexpr size_t OFF_VTA = OFF_KA + (size_t)NTOK * 128 * 2;
constexpr size_t OFF_QB = OFF_VTA + (size_t)NTOK * 128 * 2;
constexpr size_t OFF_KB = OFF_QB + (size_t)NTOK * 512 * 2;
constexpr size_t OFF_VTB = OFF_KB + (size_t)NTOK * 512 * 2;
constexpr size_t OFF_BAR = OFF_VTB + (size_t)NTOK * 512 * 2;
constexpr size_t OFF_PCNT = OFF_BAR + 16384;
constexpr size_t OFF_XBUF = OFF_PCNT + 128 * 256;
constexpr size_t OFF_MREF = OFF_XBUF + (size_t)NTOK * 4 * 4;
constexpr size_t OFF_H = OFF_XN;
static_assert(OFF_VTB + (size_t)NTOK * 512 * 2 - OFF_XN >= (size_t)NTOK * DFF * 2, "h overlay does not fit");

struct Params {
    const float *x, *norm_mix, *w_in, *q_norm_a, *k_norm_a, *rpb, *out_norm_a, *out_norm_b, *w_out, *norm_ffn, *w_gate, *w_up, *w_down, *norm_final;
    float* out;
    unsigned char* ws;
};

typedef __bf16 bf16x2_t __attribute__((ext_vector_type(2)));
DI unsigned pack2(float lo, float hi) { const f32x2 v = {lo, hi}; return __builtin_bit_cast(unsigned, __builtin_convertvector(v, bf16x2_t)); }
#define WAIT_V(n) asm volatile("s_waitcnt vmcnt(" #n ")" ::: "memory")
#define BAR __builtin_amdgcn_s_barrier()

constexpr int BM = 256, BK = 64, HALF = 128, HTB = HALF * BK * 2, STAGE_BYTES = 8 * HTB, NXCD = 8, WGM = 8;
constexpr int TAB_OFF = STAGE_BYTES;
DI int lds_byte(int r, int c) { const int st = (r >> 4) * 2 + (c >> 5), rr = r & 15, cc = c & 31, ob = rr * 64 + cc * 2; return st * 1024 + (ob ^ (((ob >> 9) & 1) << 5)); }
DI void stage_rc(int b, int& R, int& C) { const int st = b / 1024, sb = b % 1024, swz = sb ^ (((sb >> 9) & 1) << 5); R = (st >> 1) * 16 + swz / 64; C = (st & 1) * 32 + (swz % 64) / 2; }
struct Unit { int pm, pn, hn; };
struct Gemm { const bf16_t* A; const bf16_t* Bt; int K; };
struct StaticOrder {
    int nM, nN, nwg, G, c;
    DI void init(int M, int N, int G_, int c_) { nM = M / BM; nN = N / BM; nwg = nM * nN; G = G_; c = c_; }
    DI bool next(int i, Unit& u) const {
        const long L = (long)i * G + c; if (L >= nwg) return false;
        int wgid = (int)L; { const int q = nwg / NXCD, r = nwg % NXCD, xcd = wgid % NXCD, off = wgid / NXCD; wgid = (xcd < r ? xcd * (q + 1) : r * (q + 1) + (xcd - r) * q) + off; }
        const int nig = WGM * nN, gid = wgid / nig, fm = gid * WGM, gsz = (nM - fm) < WGM ? (nM - fm) : WGM;
        u.pm = fm + ((wgid % nig) % gsz); u.pn = (wgid % nig) / gsz; u.hn = 0; return true;
    }
};
struct QkvOrder {
    StaticOrder S8; int G, c;
    DI void init(int G_, int c_) { S8.init(NTOK, 8 * BM, G_, c_); G = G_; c = c_; }
    DI bool next(int i, Unit& u) const {
        const long L = (long)i * G + c;
        if (L < 1024) return S8.next(i, u);
        const int h = (int)L - 1024; if (h >= 256) return false;
        u.pm = h >> 1; u.pn = 8; u.hn = 1 + (h & 1); return true;
    }
};
typedef LAS f32x2* tab_t;

template <class Epi, class Sched>
DI void gemm_phase(LAS unsigned char* lds, const Gemm g, const Sched& S, const Epi& E) {
    const int tid = threadIdx.x, wid = __builtin_amdgcn_readfirstlane(tid >> 6), lane = tid & 63, wr = wid >> 2, wc = wid & 3, fr = lane & 15, fq = lane >> 4;
    const int K = g.K, nt = K / BK;
    unsigned voffA[2];
#pragma unroll
    for (int i = 0; i < 2; ++i) { int R, C; stage_rc(tid * 16 + i * 8192, R, C); voffA[i] = (unsigned)(R * K + C) * 2u; }
    const size_t kstep = (size_t)(BK * 2), hstep = (size_t)HALF * K * 2, tstep = 2 * hstep;
    const unsigned ldsw = (unsigned)wid * 1024u;
    const int aoff = lds_byte(wr * 64 + fr, fq * 8), boff = lds_byte(wc * 32 + fr, fq * 8);
#define G_SA(b, h) (((b) * 2 + (h)) * HTB)
#define G_SB(b, h) ((4 + (b) * 2 + (h)) * HTB)
#define G_STAGE(bufoff, gbase) do { _Pragma("unroll") for (int _i = 0; _i < 2; ++_i) \
        __builtin_amdgcn_global_load_lds((const unsigned*)((const char*)(gbase) + voffA[_i]), (LAS unsigned*)(lds + (bufoff) + ldsw + _i * 8192), 16, 0, 0); } while (0)
#define G_LDA(dst, b, h) do { _Pragma("unroll") for (int m = 0; m < 4; ++m) _Pragma("unroll") for (int k = 0; k < 2; ++k) dst[m][k] = *(const LAS bf16x8*)(lds + G_SA(b, h) + aoff + m * 2048 + k * 1024); } while (0)
#define G_LDB(dst, b, h) do { _Pragma("unroll") for (int n = 0; n < 2; ++n) _Pragma("unroll") for (int k = 0; k < 2; ++k) dst[n][k] = *(const LAS bf16x8*)(lds + G_SB(b, h) + boff + n * 2048 + k * 1024); } while (0)
#define G_MMA(ai, bj, At, Bt) do { __builtin_amdgcn_s_setprio(1); _Pragma("unroll") for (int m = 0; m < 4; ++m) _Pragma("unroll") for (int n = 0; n < 2; ++n) _Pragma("unroll") for (int k = 0; k < 2; ++k) \
        acc[ai][bj][m][n] = __builtin_amdgcn_mfma_f32_16x16x32_bf16(Bt[n][k], At[m][k], acc[ai][bj][m][n], 0, 0, 0); __builtin_amdgcn_s_setprio(0); } while (0)
#define G_WAIT_L(n) asm volatile("s_waitcnt lgkmcnt(" #n ")" ::: "memory")
#define G_SCHED __builtin_amdgcn_sched_barrier(0)
    Unit cur, nxt; int ui = 0;
    if (!S.next(0, cur)) return;
    f32x4 acc[2][2][4][2];
#pragma unroll
    for (int a = 0; a < 2; ++a)
#pragma unroll
        for (int b = 0; b < 2; ++b)
#pragma unroll
            for (int m = 0; m < 4; ++m)
#pragma unroll
                for (int n = 0; n < 2; ++n) acc[a][b][m][n] = (f32x4){0.f, 0.f, 0.f, 0.f};
    bf16x8 At[4][2], B0[2][2], B1[2][2];
    const char* cA = (const char*)g.A + (size_t)cur.pm * tstep; const char* cB = (const char*)g.Bt + (size_t)cur.pn * tstep + (cur.hn == 2 ? hstep : 0);
    if (Epi::HAS_PREP) { E.prep(cur, (tab_t)(lds + TAB_OFF)); WAIT_V(0); }
    G_STAGE(G_SB(0, 0), cB); G_STAGE(G_SB(0, 1), cB + hstep); G_STAGE(G_SA(0, 0), cA); G_STAGE(G_SA(0, 1), cA + hstep);
    if (wr == 1) BAR;
    WAIT_V(2); BAR;
    G_STAGE(G_SB(1, 0), cB + kstep); G_STAGE(G_SA(1, 0), cA + kstep); G_STAGE(G_SB(1, 1), cB + hstep + kstep);
    WAIT_V(6); BAR;
    for (;;) {
        const bool has_next = S.next(ui + 1, nxt);
        const char* nA = has_next ? (const char*)g.A + (size_t)nxt.pm * tstep : cA; const char* nB = has_next ? (const char*)g.Bt + (size_t)nxt.pn * tstep + (nxt.hn == 2 ? hstep : 0) : cB;
        tab_t tab = (tab_t)(lds + TAB_OFF + (ui & 1) * 2048);
        const bool fullw = cur.hn == 0;
        for (int t = 0; t < nt; t += 2) {
            const bool last = (t == nt - 2);
            const char* a1 = cA + (size_t)(t + 1) * kstep;
            const char* a2 = last ? nA : cA + (size_t)(t + 2) * kstep; const char* b2 = last ? nB : cB + (size_t)(t + 2) * kstep;
            const char* a3 = a2 + kstep; const char* b3 = b2 + kstep;
            if (Epi::HAS_MID) { if (t == Epi::MID_T) E.mid(acc, tab, wr, fr); }
            G_LDB(B0, 0, 0); G_LDB(B1, 0, 1); G_SCHED; G_LDA(At, 0, 0); G_STAGE(G_SA(1, 1), a1 + hstep);
            WAIT_V(8); G_WAIT_L(0); BAR; G_MMA(0, 0, At, B0); if (fullw) G_MMA(0, 1, At, B1); BAR; G_SCHED;
            G_LDA(At, 0, 1); G_STAGE(G_SB(0, 0), b2); G_STAGE(G_SB(0, 1), b2 + hstep); G_STAGE(G_SA(0, 0), a2);
            WAIT_V(8); G_WAIT_L(0); BAR; G_MMA(1, 0, At, B0); if (fullw) G_MMA(1, 1, At, B1); BAR; G_SCHED;
            G_LDB(B0, 1, 0); G_LDB(B1, 1, 1); G_SCHED; G_LDA(At, 1, 0); G_STAGE(G_SA(0, 1), a2 + hstep);
            WAIT_V(8); G_WAIT_L(0); BAR; G_MMA(0, 0, At, B0); if (fullw) G_MMA(0, 1, At, B1); BAR; G_SCHED;
            G_LDA(At, 1, 1); G_STAGE(G_SB(1, 0), b3); G_STAGE(G_SB(1, 1), b3 + hstep); G_STAGE(G_SA(1, 0), a3);
            WAIT_V(8); G_WAIT_L(0); BAR; G_MMA(1, 0, At, B0); if (fullw) G_MMA(1, 1, At, B1); BAR; G_SCHED;
        }
        if (wr == 0) BAR;
        E(acc, cur, tab, wr, wc, fr, fq, lds);
        if (!has_next) break;
#pragma unroll
        for (int a = 0; a < 2; ++a)
#pragma unroll
            for (int b = 0; b < 2; ++b)
#pragma unroll
                for (int m = 0; m < 4; ++m)
#pragma unroll
                    for (int n = 0; n < 2; ++n) acc[a][b][m][n] = (f32x4){0.f, 0.f, 0.f, 0.f};
        cur = nxt; cA = nA; cB = nB; ++ui;
        if (Epi::HAS_PREP) E.prep(cur, (tab_t)(lds + TAB_OFF + (ui & 1) * 2048));
        if (wr == 1) BAR;
    }
    WAIT_V(0);
    BAR;
#undef G_SA
#undef G_SB
#undef G_STAGE
#undef G_LDA
#undef G_LDB
#undef G_MMA
#undef G_WAIT_L
#undef G_SCHED
}

DI void store4(bf16_t* dst, f32x4 v) { u32x2 w; w.x = pack2(v[0], v[1]); w.y = pack2(v[2], v[3]); *(u32x2*)dst = w; }
DI void store8(bf16_t* dst, f32x4 a, f32x4 b) { u32x4 w; w.x = pack2(a[0], a[1]); w.y = pack2(a[2], a[3]); w.z = pack2(b[0], b[1]); w.w = pack2(b[2], b[3]); *(u32x4*)dst = w; }
DI void store1(bf16_t* dst, float v) { *dst = (bf16_t)(pack2(v, v) & 0xffffu); }
DI float sum4(f32x4 a) { return (a[0] + a[1]) + (a[2] + a[3]); }
DI float sq4(f32x4 a) { return (a[0] * a[0] + a[1] * a[1]) + (a[2] * a[2] + a[3] * a[3]); }

DI int perm_slot(int f) { const int q = f & 31; return (f & ~31) | (((q >> 2) & 1) << 4) | ((q >> 3) << 2) | (q & 3); }
DI int map_row(int f, int rowmap) {
    if (rowmap == 0) return perm_slot(f);
    if (rowmap == 1) return (f >> 7) * 256 + perm_slot(f & 127);
    if (rowmap == 2) return (f >> 7) * 256 + 128 + perm_slot(f & 127);
    if (f >= 1792) return f;
    if (f >= 768) return perm_slot(f);
    const int pn = f >> 8, w = f & 255;
    return pn * 256 + ((w >> 5) & 1) * 128 + (w >> 6) * 32 + (w & 31);
}
DI void transpose_tile(const float* __restrict__ src, int N, int k0, int n0, const float* __restrict__ gA, const float* __restrict__ gB, int gsplit,
                       bf16_t* __restrict__ dst, int ldd, int rowmap, LAS unsigned char* lds) {
    const int tid = threadIdx.x, n = tid & 63, kq = tid >> 6;
    LAS unsigned* t32 = (LAS unsigned*)lds;
#pragma unroll
    for (int i = 0; i < 4; ++i) {
        const int k = kq * 8 + 2 * i, kg = k0 + k;
        float g0 = 1.f, g1 = 1.f;
        if (gA) { g0 = kg < gsplit ? gA[kg] : gB[kg - gsplit]; g1 = (kg + 1) < gsplit ? gA[kg + 1] : gB[kg + 1 - gsplit]; }
        const float v0 = src[(size_t)kg * N + n0 + n] * g0, v1 = src[(size_t)(kg + 1) * N + n0 + n] * g1;
        t32[n * 36 + (k >> 1)] = pack2(v0, v1);
    }
    __syncthreads();
    {
        const int nn = tid >> 3, ch = tid & 7;
        const u32x4 v = *(const LAS u32x4*)(lds + nn * 144 + ch * 16);
        *(u32x4*)(dst + (size_t)map_row(n0 + nn, rowmap) * ldd + k0 + ch * 8) = v;
    }
    __syncthreads();
}

DI float wave_sum(float v) {
#pragma unroll
    for (int o = 32; o >= 1; o >>= 1) v += __shfl_xor(v, o);
    return v;
}

DI void phase0(const Params& p, LAS unsigned char* lds) {
    bf16_t* wt_in = (bf16_t*)(p.ws + OFF_WT_IN);
    bf16_t* wt_out = (bf16_t*)(p.ws + OFF_WT_OUT);
    bf16_t* wt_gu = (bf16_t*)(p.ws + OFF_WT_GU);
    bf16_t* wt_dn = (bf16_t*)(p.ws + OFF_WT_DN);
    for (int j = blockIdx.x; j < 2944; j += gridDim.x) {
        if (j < 576) { const int kt = j / 36, nt = j % 36; transpose_tile(p.w_in, INW, kt * 64, nt * 64, p.norm_mix, p.norm_mix, DM, wt_in, DM, 3, lds); }
        else if (j < 832) { const int jj = j - 576, kt = jj / 16, nt = jj % 16; transpose_tile(p.w_out, DM, kt * 64, nt * 64, p.out_norm_a, p.out_norm_b, 512, wt_out, DM, 0, lds); }
        else if (j < 1536) { const int jj = j - 832, kt = jj / 44, nt = jj % 44; transpose_tile(p.w_gate, DFF, kt * 64, nt * 64, p.norm_ffn, p.norm_ffn, DM, wt_gu, DM, 1, lds); }
        else if (j < 2240) { const int jj = j - 1536, kt = jj / 44, nt = jj % 44; transpose_tile(p.w_up, DFF, kt * 64, nt * 64, p.norm_ffn, p.norm_ffn, DM, wt_gu, DM, 2, lds); }
        else { const int jj = j - 2240, kt = jj / 16, nt = jj % 16; transpose_tile(p.w_down, DM, kt * 64, nt * 64, nullptr, nullptr, 0, wt_dn, DFF, 0, lds); }
    }
    bf16_t* xn = (bf16_t*)(p.ws + OFF_XN);
    const int lane = threadIdx.x & 63, w = threadIdx.x >> 6;
    for (int row = blockIdx.x * 8 + w; row < NTOK; row += gridDim.x * 8) {
        const f32x4* xr = (const f32x4*)(p.x + (size_t)row * DM);
        f32x4 v[4]; float ss = 0.f;
#pragma unroll
        for (int i = 0; i < 4; ++i) { v[i] = __builtin_nontemporal_load(xr + lane + 64 * i); ss += sq4(v[i]); }
        ss = wave_sum(ss);
        const float rs = rsqrtf(ss * (1.0f / DM) + EPS);
#pragma unroll
        for (int i = 0; i < 4; ++i) store4(xn + (size_t)row * DM + (lane + 64 * i) * 4, v[i] * rs);
    }
    if (blockIdx.x == 0 && threadIdx.x < 64) {
        float gq = fabsf(p.q_norm_a[threadIdx.x]), gk = fabsf(p.k_norm_a[threadIdx.x]);
#pragma unroll
        for (int o = 32; o >= 1; o >>= 1) { gq = fmaxf(gq, __shfl_xor(gq, o)); gk = fmaxf(gk, __shfl_xor(gk, o)); }
        if (threadIdx.x == 0) *(float*)(p.ws + OFF_MREF) = 8.0f * LOG2E * gq * gk * 1.02f + 0.1f;
    }
    const int gt = blockIdx.x * 512 + threadIdx.x;
    if (gt < 2048) {
        const int pos = gt >> 4, i = gt & 15;
        const float invf = __builtin_amdgcn_exp2f(-(float)i * 0.830482023721841f);
        const float ang = (float)pos * invf;
        double rev = (double)ang * 0.15915494309189535;
        rev -= __builtin_rint(rev);
        const float rv = (float)rev;
        f32x2 cs; cs.x = __builtin_amdgcn_cosf(rv); cs.y = __builtin_amdgcn_sinf(rv);
        ((f32x2*)(p.ws + OFF_ROPE))[gt] = cs;
    }
}

struct EpiQKV {
    static constexpr bool HAS_PREP = false, HAS_MID = false; static constexpr int MID_T = -1;
    const float *qg, *kg; unsigned char* ws;
    DI void prep(const Unit&, tab_t) const {}
    DI void mid(f32x4 (&)[2][2][4][2], tab_t, int, int) const {}
    DI void rope_heads(const f32x4 (&acc)[2][2][4][2], const float* __restrict__ gain, float scale, bf16_t* __restrict__ dst, int ldd, int row0, int fr, int fq) const {
        const f32x4* rope = (const f32x4*)(ws + OFF_ROPE);
        f32x4 g[2][2];
#pragma unroll
        for (int bj = 0; bj < 2; ++bj)
#pragma unroll
            for (int n = 0; n < 2; ++n) g[bj][n] = *(const f32x4*)(gain + 32 * bj + 16 * n + 4 * fq);
#pragma unroll
        for (int ai = 0; ai < 2; ++ai)
#pragma unroll
            for (int m = 0; m < 4; ++m) {
                const int t = row0 + ai * HALF + m * 16 + fr;
                float ss = (sq4(acc[ai][0][m][0]) + sq4(acc[ai][0][m][1])) + (sq4(acc[ai][1][m][0]) + sq4(acc[ai][1][m][1]));
                ss += __shfl_xor(ss, 16); ss += __shfl_xor(ss, 32);
                const float rs = rsqrtf(ss * (1.0f / 64.0f) + EPS);
                const int sidx = t & (SEQL - 1), row = sidx >> 6, col = sidx & 63;
                bf16_t* d = dst + (size_t)t * ldd + fq * 4;
#pragma unroll
                for (int bj = 0; bj < 2; ++bj) {
                    const int pos = bj == 0 ? row : col;
                    const f32x4 t0 = rope[(pos * 16 + fq * 4) >> 1], t1 = rope[((pos * 16 + fq * 4) >> 1) + 1];
                    const float c[4] = {t0[0], t0[2], t1[0], t1[2]}, sn[4] = {t0[1], t0[3], t1[1], t1[3]};
                    f32x4 o0, o1;
#pragma unroll
                    for (int j = 0; j < 4; ++j) {
                        const float x1 = acc[ai][bj][m][0][j] * rs * g[bj][0][j], x2 = acc[ai][bj][m][1][j] * rs * g[bj][1][j];
                        o0[j] = (x1 * c[j] - x2 * sn[j]) * scale; o1[j] = (x2 * c[j] + x1 * sn[j]) * scale;
                    }
                    store4(d + 32 * bj, o0); store4(d + 32 * bj + 16, o1);
                }
            }
    }
    DI void vt_heads(const f32x4 (&acc)[2][2][4][2], bf16_t* __restrict__ base, int dsel  , int row0, int wc, int fr, int fq, int hn = 0) const {
#pragma unroll
        for (int ai = 0; ai < 2; ++ai)
#pragma unroll
            for (int m = 0; m < 4; ++m) {
                const int t = row0 + ai * HALF + m * 16 + fr, b = t >> 13, sidx = t & (SEQL - 1);
#pragma unroll
                for (int bjr = 0; bjr < 2; ++bjr) {
                    if (hn != 0 && bjr == 1) continue;
                    const int bj = hn ? hn - 1 : bjr;
#pragma unroll
                    for (int n = 0; n < 2; ++n) {
                        bf16_t* dp = dsel == 0 ? base + ((size_t)(b * 2) * 64 + 32 * bj + 16 * n + 4 * fq) * SEQL + sidx
                                               : base + ((size_t)(b * 8 + 2 * bj + (wc >> 1)) * 64 + (wc & 1) * 32 + 16 * n + 4 * fq) * SEQL + sidx;
#pragma unroll
                        for (int j = 0; j < 4; ++j) store1(dp + (size_t)j * SEQL, acc[ai][bjr][m][n][j]);
                    }
                }
            }
    }
    DI void operator()(f32x4 (&acc)[2][2][4][2], const Unit& u, tab_t, int wr, int wc, int fr, int fq, LAS unsigned char*) const {
        const int pn = u.pn, row0 = u.pm * BM + wr * 64;
        if (pn <= 1) {
            rope_heads(acc, qg, QSCALE, (bf16_t*)(ws + OFF_QA) + (pn * 4 + wc) * 64, 512, row0, fr, fq);
        } else if (pn == 2) {
            if (wc < 2) rope_heads(acc, kg, 1.0f, (bf16_t*)(ws + OFF_KA) + wc * 64, 128, row0, fr, fq);
            else vt_heads(acc, (bf16_t*)(ws + OFF_VTA) + (size_t)(wc - 2) * 64 * SEQL, 0, row0, wc, fr, fq);
        } else if (pn <= 6) {
            const bool isq = pn <= 4;
            bf16_t* base = isq ? (bf16_t*)(ws + OFF_QB) + (pn - 3) * 256 : (bf16_t*)(ws + OFF_KB) + (pn - 5) * 256;
            const float sc = isq ? QSCALE : 1.0f;
#pragma unroll
            for (int ai = 0; ai < 2; ++ai)
#pragma unroll
                for (int m = 0; m < 4; ++m) {
                    bf16_t* d = base + (size_t)(row0 + ai * HALF + m * 16 + fr) * 512 + wc * 32 + fq * 8;
#pragma unroll
                    for (int bj = 0; bj < 2; ++bj) store8(d + bj * HALF, acc[ai][bj][m][0] * sc, acc[ai][bj][m][1] * sc);
                }
        } else {
            vt_heads(acc, (bf16_t*)(ws + OFF_VTB) + (size_t)(pn - 7) * 4 * 64 * SEQL, 1, row0, wc, fr, fq, u.hn);
        }
    }
};

DI void phase1(const Params& p, LAS unsigned char* lds) {
    QkvOrder S; S.init(gridDim.x, blockIdx.x);
    Gemm g{(const bf16_t*)(p.ws + OFF_XN), (const bf16_t*)(p.ws + OFF_WT_IN), DM};
    EpiQKV E{p.q_norm_a, p.k_norm_a, p.ws};
    gemm_phase<EpiQKV, QkvOrder>(lds, g, S, E);
}

constexpr int AT_NS = 8, AT_D = AT_NS - 1, AT_STG = 16384, AT_RPB = AT_NS * AT_STG;
DI float max3(float a, float b, float c) { return __builtin_fmaxf(__builtin_fmaxf(a, b), c); }
template <bool NAT, bool STATIC>
DI void attn_unit(const Params& p, int unit, LAS unsigned char* lds) {
    const int tid = threadIdx.x, lane = tid & 63, w = __builtin_amdgcn_readfirstlane(tid >> 6), r = lane & 31, h = lane >> 5;
    const int b = unit >> 8, rem = unit & 255;
    int head, t0, ldk, key0, ntiles, ocol, hslot;
    const bf16_t *Qp, *Kp, *Vtp;
    int rw = 0, rsw = 0, krow0 = 0;
    if (!NAT) {
        const int xcd = rem & 7, rest = rem >> 3, kvh = xcd & 1, idx = (xcd >> 1) + 4 * rest, hq = idx >> 5, qb = idx & 31;
        head = kvh * 4 + hq; t0 = b * SEQL + qb * 256;
        Qp = (const bf16_t*)(p.ws + OFF_QA) + (size_t)t0 * 512 + head * 64;
        Kp = (const bf16_t*)(p.ws + OFF_KA) + (size_t)b * SEQL * 128 + kvh * 64; ldk = 128;
        Vtp = (const bf16_t*)(p.ws + OFF_VTA) + (size_t)(b * 2 + kvh) * 64 * SEQL;
        key0 = 0; ntiles = 128; ocol = head * 64; hslot = head;
    } else {
        head = rem & 7; const int rq = rem >> 3; t0 = b * SEQL + rq * 256;
        Qp = (const bf16_t*)(p.ws + OFF_QB) + (size_t)t0 * 512 + head * 64;
        Kp = (const bf16_t*)(p.ws + OFF_KB) + (size_t)b * SEQL * 512 + head * 64; ldk = 512;
        Vtp = (const bf16_t*)(p.ws + OFF_VTB) + (size_t)(b * 8 + head) * 64 * SEQL;
        const int r0 = 4 * rq, rsA = min(max(r0 - 4, 0), 120), rsB = min(max(r0 - 1, 0), 120);
        krow0 = rsA; key0 = rsA * 64; ntiles = rsB + 8 - rsA; ocol = 512 + head * 64; hslot = 8 + head;
        rw = r0 + (w >> 1); rsw = min(max(rw - 4, 0), 120);
    }
    bf16x8 qf[4];
#pragma unroll
    for (int ks = 0; ks < 4; ++ks) qf[ks] = *(const bf16x8*)(Qp + (size_t)(w * 32 + r) * 512 + ks * 16 + h * 8);
    asm volatile("s_waitcnt vmcnt(0)" ::: "memory");
    __syncthreads();
    if (NAT) {
        LAS float* rl = (LAS float*)(lds + AT_RPB);
        for (int i = tid; i < 64 + 465 + 64; i += 512) rl[i] = (i >= 64 && i < 64 + 465) ? p.rpb[head * 465 + i - 64] * LOG2E : 0.f;
        asm volatile("s_waitcnt vmcnt(0)" ::: "memory");
    }
    const int srow = tid >> 3, slc = (tid & 7) ^ ((srow >> 1) & 7);
    const bf16_t* kg = Kp + (size_t)(key0 + srow) * ldk + slc * 8;
    const bf16_t* vg = Vtp + (size_t)srow * SEQL + key0 + slc * 8;
    const unsigned ldsw = (unsigned)w * 1024u;
#define ISSUE_TILE(tt) do { const int _t = min((tt), ntiles - 1); const int _s = (tt) & (AT_NS - 1); \
        __builtin_amdgcn_global_load_lds((const unsigned*)(kg + (size_t)_t * 64 * ldk), (LAS unsigned*)(lds + _s * AT_STG + ldsw), 16, 0, 0); \
        __builtin_amdgcn_global_load_lds((const unsigned*)(vg + _t * 64), (LAS unsigned*)(lds + _s * AT_STG + 8192 + ldsw), 16, 0, 0); } while (0)
#pragma unroll
    for (int i = 0; i < AT_D - 1; ++i) ISSUE_TILE(i);
    f32x16 o0, o1, cinit;
#pragma unroll
    for (int i = 0; i < 16; ++i) { o0[i] = 0.f; o1[i] = 0.f; cinit[i] = 0.f; }
    float lsum = 0.f;
    bool first = true;
    const int pir = (r & 0x13) | ((r & 4) << 1) | ((r & 8) >> 1);
    int kofs[4], vofs[4];
#pragma unroll
    for (int i = 0; i < 4; ++i) {
        kofs[i] = pir * 128 + (((i * 2 + h) ^ ((pir >> 1) & 7)) << 4);
        vofs[i] = 8192 + r * 128 + (((i * 2 + h) ^ ((r >> 1) & 7)) << 4);
    }
    const int qc = (w & 1) * 32 + r, cs = min(max(qc - 8, 0), 48);
    f32x16 cinitB;
#pragma unroll
    for (int i = 0; i < 16; ++i) cinitB[i] = 0.f;
    if (NAT) {
#pragma unroll
        for (int g = 0; g < 16; ++g) { const int kc0 = 16 * (g >> 3) + 8 * h + (g & 7);
            cinit[g] = ((unsigned)(kc0 - cs) < 16u) ? 0.f : -1e30f; cinitB[g] = ((unsigned)(kc0 + 32 - cs) < 16u) ? 0.f : -1e30f; }
    }
    constexpr float THR = 8.0f;
#define TILE_ACTIVE(t) (!NAT || ((krow0 + (t)) >= rsw && (krow0 + (t)) < rsw + 8))
#define FENCE __builtin_amdgcn_sched_barrier(0x407)
#define QK_TILE(tt, d0, d1) do { LAS unsigned char* _sb = lds + ((tt) & (AT_NS - 1)) * AT_STG; \
        bf16x8 ka0 = *(const LAS bf16x8*)(_sb + kofs[0]), ka1 = *(const LAS bf16x8*)(_sb + kofs[0] + 4096); \
        bf16x8 kb0 = *(const LAS bf16x8*)(_sb + kofs[1]), kb1 = *(const LAS bf16x8*)(_sb + kofs[1] + 4096); \
        FENCE; __builtin_amdgcn_s_setprio(2); \
        d0 = __builtin_amdgcn_mfma_f32_32x32x16_bf16(ka0, qf[0], cinit, 0, 0, 0); d1 = __builtin_amdgcn_mfma_f32_32x32x16_bf16(ka1, qf[0], NAT ? cinitB : cinit, 0, 0, 0); \
        ka0 = *(const LAS bf16x8*)(_sb + kofs[2]); ka1 = *(const LAS bf16x8*)(_sb + kofs[2] + 4096); \
        FENCE; \
        d0 = __builtin_amdgcn_mfma_f32_32x32x16_bf16(kb0, qf[1], d0, 0, 0, 0); d1 = __builtin_amdgcn_mfma_f32_32x32x16_bf16(kb1, qf[1], d1, 0, 0, 0); \
        kb0 = *(const LAS bf16x8*)(_sb + kofs[3]); kb1 = *(const LAS bf16x8*)(_sb + kofs[3] + 4096); \
        FENCE; \
        d0 = __builtin_amdgcn_mfma_f32_32x32x16_bf16(ka0, qf[2], d0, 0, 0, 0); d1 = __builtin_amdgcn_mfma_f32_32x32x16_bf16(ka1, qf[2], d1, 0, 0, 0); \
        FENCE; \
        d0 = __builtin_amdgcn_mfma_f32_32x32x16_bf16(kb0, qf[3], d0, 0, 0, 0); d1 = __builtin_amdgcn_mfma_f32_32x32x16_bf16(kb1, qf[3], d1, 0, 0, 0); \
        __builtin_amdgcn_s_setprio(0); FENCE; } while (0)
#define STEP(T, A0, A1, B0, B1, MODE) do { \
        if (((T) + 1 < ntiles) && TILE_ACTIVE((T) + 1)) QK_TILE((T) + 1, B0, B1); \
        if (TILE_ACTIVE(T)) { \
            LAS unsigned char* sb = lds + ((T) & (AT_NS - 1)) * AT_STG; \
            if (NAT) { \
                const LAS float* rb = (const LAS float*)(lds + AT_RPB) + 64 + (krow0 + (T) - rw + 7) * 31 - qc + 15 + 8 * h; \
                _Pragma("unroll") for (int g = 0; g < 16; ++g) { A0[g] += rb[16 * (g >> 3) + (g & 7)]; A1[g] += rb[32 + 16 * (g >> 3) + (g & 7)]; } \
            } \
            if ((MODE) != 2) { \
            float mx = max3(A0[0], A1[0], A0[1]); \
            mx = max3(mx, A1[1], A0[2]); \
            _Pragma("unroll") for (int i = 2; i < 15; ++i) mx = max3(mx, A1[i], A0[i + 1]); \
            mx = fmaxf(mx, A1[15]); \
            { auto sw = __builtin_amdgcn_permlane32_swap(__float_as_uint(mx), __float_as_uint(mx), false, false); \
              mx = fmaxf(__uint_as_float(sw[0]), __uint_as_float(sw[1])); } \
            if (first || __builtin_amdgcn_ballot_w64(mx > THR) != 0ull) {            \
                asm volatile("" ::: "memory");                                        \
                const float delta = (first || mx > THR) ? mx : 0.f; \
                const float alpha = __builtin_amdgcn_exp2f(-delta); \
                lsum *= alpha; \
                _Pragma("unroll") for (int i = 0; i < 16; ++i) { o0[i] *= alpha; o1[i] *= alpha; A0[i] -= delta; A1[i] -= delta; B0[i] -= delta; B1[i] -= delta; cinit[i] -= delta; if (NAT) cinitB[i] -= delta; } \
                first = false; \
            } \
            } \
            bf16x8 va0 = *(const LAS bf16x8*)(sb + vofs[0]), va1 = *(const LAS bf16x8*)(sb + vofs[0] + 4096); \
            bf16x8 vb0 = *(const LAS bf16x8*)(sb + vofs[1]), vb1 = *(const LAS bf16x8*)(sb + vofs[1] + 4096); \
            FENCE; __builtin_amdgcn_s_setprio(1); \
            float ps = 0.f; \
            _Pragma("unroll") for (int i = 0; i < 16; ++i) { A0[i] = __builtin_amdgcn_exp2f(A0[i]); A1[i] = __builtin_amdgcn_exp2f(A1[i]); ps += A0[i]; ps += A1[i]; } \
            lsum += ps; \
            u32x4 pw; bf16x8 pf; \
            pw.x = pack2(A0[0], A0[1]); pw.y = pack2(A0[2], A0[3]); pw.z = pack2(A0[4], A0[5]); pw.w = pack2(A0[6], A0[7]); pf = __builtin_bit_cast(bf16x8, pw); \
            o0 = __builtin_amdgcn_mfma_f32_32x32x16_bf16(va0, pf, o0, 0, 0, 0); o1 = __builtin_amdgcn_mfma_f32_32x32x16_bf16(va1, pf, o1, 0, 0, 0); \
            va0 = *(const LAS bf16x8*)(sb + vofs[2]); va1 = *(const LAS bf16x8*)(sb + vofs[2] + 4096); \
            FENCE; \
            pw.x = pack2(A0[8], A0[9]); pw.y = pack2(A0[10], A0[11]); pw.z = pack2(A0[12], A0[13]); pw.w = pack2(A0[14], A0[15]); pf = __builtin_bit_cast(bf16x8, pw); \
            o0 = __builtin_amdgcn_mfma_f32_32x32x16_bf16(vb0, pf, o0, 0, 0, 0); o1 = __builtin_amdgcn_mfma_f32_32x32x16_bf16(vb1, pf, o1, 0, 0, 0); \
            vb0 = *(const LAS bf16x8*)(sb + vofs[3]); vb1 = *(const LAS bf16x8*)(sb + vofs[3] + 4096); \
            FENCE; \
            pw.x = pack2(A1[0], A1[1]); pw.y = pack2(A1[2], A1[3]); pw.z = pack2(A1[4], A1[5]); pw.w = pack2(A1[6], A1[7]); pf = __builtin_bit_cast(bf16x8, pw); \
            o0 = __builtin_amdgcn_mfma_f32_32x32x16_bf16(va0, pf, o0, 0, 0, 0); o1 = __builtin_amdgcn_mfma_f32_32x32x16_bf16(va1, pf, o1, 0, 0, 0); \
            FENCE; \
            pw.x = pack2(A1[8], A1[9]); pw.y = pack2(A1[10], A1[11]); pw.z = pack2(A1[12], A1[13]); pw.w = pack2(A1[14], A1[15]); pf = __builtin_bit_cast(bf16x8, pw); \
            o0 = __builtin_amdgcn_mfma_f32_32x32x16_bf16(vb0, pf, o0, 0, 0, 0); o1 = __builtin_amdgcn_mfma_f32_32x32x16_bf16(vb1, pf, o1, 0, 0, 0); \
            __builtin_amdgcn_s_setprio(0); FENCE; \
        } } while (0)
    asm volatile("s_waitcnt vmcnt(10) lgkmcnt(0)" ::: "memory");
    BAR;
    if (STATIC) {
        const float mref = *(const float*)(p.ws + OFF_MREF);
#pragma unroll
        for (int i = 0; i < 16; ++i) cinit[i] = -mref;
        first = false;
    }
    f32x16 s0, s1, n0, n1;
    if (TILE_ACTIVE(0)) QK_TILE(0, s0, s1);
    for (int t = 0; t < ntiles; t += 2) {
        asm volatile("s_waitcnt vmcnt(6) lgkmcnt(0)" ::: "memory");
        BAR;
        ISSUE_TILE(t + 6); ISSUE_TILE(t + 7);
        STEP(t, s0, s1, n0, n1, (STATIC ? 2 : 0)); if (t + 1 < ntiles) STEP(t + 1, n0, n1, s0, s1, (STATIC ? 2 : 0));
    }
#undef STEP
#undef ISSUE_TILE
#undef TILE_ACTIVE
#undef QK_TILE
#undef FENCE
    { auto sw = __builtin_amdgcn_permlane32_swap(__float_as_uint(lsum), __float_as_uint(lsum), false, false);
      lsum = __uint_as_float(sw[0]) + __uint_as_float(sw[1]); }
    const float linv = 1.0f / lsum;
    const int tok = t0 + w * 32 + r;
    bf16_t* od = (bf16_t*)(p.ws + OFF_OMIX) + (size_t)tok * DM + ocol + 4 * h;
    float ss = 0.f;
#pragma unroll
    for (int gq = 0; gq < 4; ++gq) {
        f32x4 a = {o0[gq * 4] * linv, o0[gq * 4 + 1] * linv, o0[gq * 4 + 2] * linv, o0[gq * 4 + 3] * linv};
        f32x4 c = {o1[gq * 4] * linv, o1[gq * 4 + 1] * linv, o1[gq * 4 + 2] * linv, o1[gq * 4 + 3] * linv};
        ss += sq4(a) + sq4(c);
        store4(od + 8 * gq, a); store4(od + 32 + 8 * gq, c);
    }
    ss += __shfl_xor(ss, 32);
    if (h == 0) ((float*)(p.ws + OFF_SSO))[(size_t)tok * 16 + hslot] = ss;
}

DI void phase2(const Params& p, LAS unsigned char* lds) {
    const bool use_static = *(const float*)(p.ws + OFF_MREF) <= 40.0f;
    for (int u = blockIdx.x; u < 2048; u += gridDim.x) {
        if (u < 1024) { if (use_static) attn_unit<false, true>(p, u, lds); else attn_unit<false, false>(p, u, lds); }
        else attn_unit<true, false>(p, u - 1024, lds);
    }
}

struct EpiOut {
    static constexpr bool HAS_PREP = true, HAS_MID = true; static constexpr int MID_T = 8;
    const float* x; float* out; unsigned char* ws;
    DI void prep(const Unit& u, tab_t tab) const {
        const int tid = threadIdx.x;
        if (tid < 256) {
            const f32x4* s = (const f32x4*)((const float*)(ws + OFF_SSO) + (size_t)(u.pm * BM + tid) * 16);
            const float sa = sum4(s[0]) + sum4(s[1]), sb = sum4(s[2]) + sum4(s[3]);
            const float ra = rsqrtf(sa * (1.0f / 512.0f) + EPS), rb = rsqrtf(sb * (1.0f / 512.0f) + EPS);
            tab[tid] = (f32x2){ra / rb, rb};
        }
    }
    DI void mid(f32x4 (&acc)[2][2][4][2], tab_t tab, int wr, int fr) const {
#pragma unroll
        for (int ai = 0; ai < 2; ++ai)
#pragma unroll
            for (int m = 0; m < 4; ++m) {
                const float rt = tab[ai * HALF + wr * 64 + m * 16 + fr].x;
#pragma unroll
                for (int bj = 0; bj < 2; ++bj)
#pragma unroll
                    for (int n = 0; n < 2; ++n) acc[ai][bj][m][n] *= rt;
            }
    }
    DI void operator()(f32x4 (&acc)[2][2][4][2], const Unit& u, tab_t tab, int wr, int wc, int fr, int fq, LAS unsigned char*) const {
        bf16_t* x1b = (bf16_t*)(ws + OFF_X1B);
        float* ss2 = (float*)(ws + OFF_SS2);
#pragma unroll
        for (int ai = 0; ai < 2; ++ai) {
            f32x4 xv[4][2][2];
#pragma unroll
            for (int m = 0; m < 4; ++m) {
                const size_t off = (size_t)(u.pm * BM + ai * HALF + wr * 64 + m * 16 + fr) * DM + u.pn * BM + wc * 32 + fq * 8;
#pragma unroll
                for (int bj = 0; bj < 2; ++bj)
#pragma unroll
                    for (int n = 0; n < 2; ++n) xv[m][bj][n] = *(const f32x4*)(x + off + bj * HALF + n * 4);
            }
#pragma unroll
            for (int m = 0; m < 4; ++m) {
                const int rl = ai * HALF + wr * 64 + m * 16 + fr, t = u.pm * BM + rl;
                const float rb = tab[rl].y;
                const size_t off = (size_t)t * DM + u.pn * BM + wc * 32 + fq * 8;
                float ss = 0.f;
#pragma unroll
                for (int bj = 0; bj < 2; ++bj) {
                    const f32x4 v0 = xv[m][bj][0] + acc[ai][bj][m][0] * rb, v1 = xv[m][bj][1] + acc[ai][bj][m][1] * rb;
                    ss += sq4(v0) + sq4(v1);
                    store8(x1b + off + bj * HALF, v0, v1);
                }
                ss += __shfl_xor(ss, 16); ss += __shfl_xor(ss, 32);
                if (fq == 0) ss2[(size_t)t * 16 + u.pn * 4 + wc] = ss;
            }
            asm volatile("" ::: "memory");
        }
    }
};
DI void phase3(const Params& p, LAS unsigned char* lds) {
    StaticOrder S; S.init(NTOK, DM, gridDim.x, blockIdx.x);
    Gemm g{(const bf16_t*)(p.ws + OFF_OMIX), (const bf16_t*)(p.ws + OFF_WT_OUT), DM};
    EpiOut E{p.x, p.out, p.ws};
    gemm_phase<EpiOut, StaticOrder>(lds, g, S, E);
}

struct EpiGU {
    static constexpr bool HAS_PREP = true, HAS_MID = false; static constexpr int MID_T = -1;
    unsigned char* ws;
    DI void prep(const Unit& u, tab_t tab) const {
        const int tid = threadIdx.x;
        if (tid < 256) {
            const f32x4* s = (const f32x4*)((const float*)(ws + OFF_SS2) + (size_t)(u.pm * BM + tid) * 16);
            const float sa = (sum4(s[0]) + sum4(s[1])) + (sum4(s[2]) + sum4(s[3]));
            tab[tid] = (f32x2){rsqrtf(sa * (1.0f / DM) + EPS), 0.f};
        }
    }
    DI void mid(f32x4 (&)[2][2][4][2], tab_t, int, int) const {}
    DI void operator()(f32x4 (&acc)[2][2][4][2], const Unit& u, tab_t tab, int wr, int wc, int fr, int fq, LAS unsigned char*) const {
        bf16_t* hbuf = (bf16_t*)(ws + OFF_H);
#pragma unroll
        for (int ai = 0; ai < 2; ++ai)
#pragma unroll
            for (int m = 0; m < 4; ++m) {
                const int rl = ai * HALF + wr * 64 + m * 16 + fr;
                const float rs = tab[rl].x;
                bf16_t* d = hbuf + (size_t)(u.pm * BM + rl) * DFF + u.pn * 128 + wc * 32 + fq * 8;
                f32x4 o[2];
#pragma unroll
                for (int n = 0; n < 2; ++n) {
#pragma unroll
                    for (int j = 0; j < 4; ++j) {
                        const float g = acc[ai][0][m][n][j] * rs, uu = acc[ai][1][m][n][j] * rs;
                        o[n][j] = g * uu * __builtin_amdgcn_rcpf(1.0f + __builtin_amdgcn_exp2f(-g * LOG2E));
                    }
                }
                store8(d, o[0], o[1]);
            }
    }
};
DI void phase4(const Params& p, LAS unsigned char* lds) {
    StaticOrder S; S.init(NTOK, 2 * DFF, gridDim.x, blockIdx.x);
    Gemm g{(const bf16_t*)(p.ws + OFF_X1B), (const bf16_t*)(p.ws + OFF_WT_GU), DM};
    EpiGU E{p.ws};
    gemm_phase<EpiGU, StaticOrder>(lds, g, S, E);
}

struct EpiDown {
    static constexpr bool HAS_PREP = false, HAS_MID = false; static constexpr int MID_T = -1;
    float* out; unsigned char* ws; const float* gfin;
    DI void prep(const Unit&, tab_t) const {}
    DI void mid(f32x4 (&)[2][2][4][2], tab_t, int, int) const {}
    DI void operator()(f32x4 (&acc)[2][2][4][2], const Unit& u, tab_t, int wr, int wc, int fr, int fq, LAS unsigned char* lds) const {
        const bf16_t* x1b = (const bf16_t*)(ws + OFF_X1B);
        float* xbuf = (float*)(ws + OFF_XBUF);
        unsigned* cnt = (unsigned*)(ws + OFF_PCNT) + 64 * u.pm;
        LAS float* P = (LAS float*)(lds + TAB_OFF);
        LAS float* S = (LAS float*)(lds + TAB_OFF + 4096);
        const int tid = threadIdx.x;
#pragma unroll
        for (int ai = 0; ai < 2; ++ai) {
            u32x4 xv[4][2];
#pragma unroll
            for (int m = 0; m < 4; ++m) {
                const size_t off = (size_t)(u.pm * BM + ai * HALF + wr * 64 + m * 16 + fr) * DM + u.pn * BM + wc * 32 + fq * 8;
#pragma unroll
                for (int bj = 0; bj < 2; ++bj) xv[m][bj] = *(const u32x4*)(x1b + off + bj * HALF);
            }
#pragma unroll
            for (int m = 0; m < 4; ++m) {
                float ss = 0.f;
#pragma unroll
                for (int bj = 0; bj < 2; ++bj) {
                    const u32x4 w = xv[m][bj];
                    const f32x4 x0 = {__uint_as_float(w.x << 16), __uint_as_float(w.x & 0xffff0000u), __uint_as_float(w.y << 16), __uint_as_float(w.y & 0xffff0000u)};
                    const f32x4 x1 = {__uint_as_float(w.z << 16), __uint_as_float(w.z & 0xffff0000u), __uint_as_float(w.w << 16), __uint_as_float(w.w & 0xffff0000u)};
                    acc[ai][bj][m][0] += x0; acc[ai][bj][m][1] += x1;
                    ss += sq4(acc[ai][bj][m][0]) + sq4(acc[ai][bj][m][1]);
                }
                ss += __shfl_xor(ss, 16); ss += __shfl_xor(ss, 32);
                if (fq == 0) P[(ai * HALF + wr * 64 + m * 16 + fr) * 4 + wc] = ss;
            }
            asm volatile("" ::: "memory");
        }
        asm volatile("s_waitcnt lgkmcnt(0)" ::: "memory"); BAR; asm volatile("" ::: "memory");
        if (tid < 256) {
            const f32x4 pp = *(const LAS f32x4*)(P + tid * 4);
            __hip_atomic_store(xbuf + (size_t)(u.pm * BM + tid) * 4 + u.pn, (pp[0] + pp[1]) + (pp[2] + pp[3]), __ATOMIC_RELAXED, __HIP_MEMORY_SCOPE_AGENT);
            asm volatile("s_waitcnt vmcnt(0)" ::: "memory");
            if ((tid & 63) == 0) __hip_atomic_fetch_add(cnt, 1u, __ATOMIC_RELAXED, __HIP_MEMORY_SCOPE_AGENT);
        }
        if (tid < 64) {
            for (unsigned it = 0; (unsigned)__builtin_amdgcn_readfirstlane((int)__hip_atomic_load(cnt, __ATOMIC_RELAXED, __HIP_MEMORY_SCOPE_AGENT)) < 16u && it < (1u << 22); ++it) __builtin_amdgcn_s_sleep(2);
            __builtin_amdgcn_fence(__ATOMIC_ACQUIRE, "agent");
            asm volatile("s_waitcnt vmcnt(0)" ::: "memory");
        }
        asm volatile("s_waitcnt vmcnt(0) lgkmcnt(0)" ::: "memory"); BAR; asm volatile("" ::: "memory");
        if (tid < 256) {
            const unsigned long long* slot = (const unsigned long long*)(xbuf + (size_t)(u.pm * BM + tid) * 4);
            const unsigned long long w0 = __hip_atomic_load(slot, __ATOMIC_RELAXED, __HIP_MEMORY_SCOPE_AGENT), w1 = __hip_atomic_load(slot + 1, __ATOMIC_RELAXED, __HIP_MEMORY_SCOPE_AGENT);
            const float q = (__uint_as_float((unsigned)w0) + __uint_as_float((unsigned)(w0 >> 32))) + (__uint_as_float((unsigned)w1) + __uint_as_float((unsigned)(w1 >> 32)));
            S[tid] = rsqrtf(q * (1.0f / DM) + EPS);
        }
        asm volatile("s_waitcnt lgkmcnt(0)" ::: "memory"); BAR; asm volatile("" ::: "memory");
        f32x4 gv[2][2];
#pragma unroll
        for (int bj = 0; bj < 2; ++bj)
#pragma unroll
            for (int n = 0; n < 2; ++n) gv[bj][n] = *(const f32x4*)(gfin + u.pn * BM + bj * HALF + wc * 32 + fq * 8 + n * 4);
#pragma unroll
        for (int ai = 0; ai < 2; ++ai)
#pragma unroll
            for (int m = 0; m < 4; ++m) {
                const int rl = ai * HALF + wr * 64 + m * 16 + fr;
                const float rs = S[rl];
                float* o = out + (size_t)(u.pm * BM + rl) * DM + u.pn * BM + wc * 32 + fq * 8;
#pragma unroll
                for (int bj = 0; bj < 2; ++bj) {
                    *(f32x4*)(o + bj * HALF) = acc[ai][bj][m][0] * rs * gv[bj][0];
                    *(f32x4*)(o + bj * HALF + 4) = acc[ai][bj][m][1] * rs * gv[bj][1];
                }
            }
    }
};
DI void phase5(const Params& p, LAS unsigned char* lds) {
    StaticOrder S; S.init(NTOK, DM, gridDim.x, blockIdx.x);
    Gemm g{(const bf16_t*)(p.ws + OFF_H), (const bf16_t*)(p.ws + OFF_WT_DN), DFF};
    EpiDown E{p.out, p.ws, p.norm_final};
    gemm_phase<EpiDown, StaticOrder>(lds, g, S, E);
}

#define XB_TMO      128
#define XB_XCNT(j)  (256  + 64 * (j))
#define XB_XSUB(j)  (1280 + 64 * (j))
#define XB_XGEN(j)  (2304 + 64 * (j))
#define XB_TOP      3328
#define XB_TOPGEN   3392
#define XCD_BAR_WORDS 3456
#define XB_SPIN_CAP (1u << 20)
DI unsigned xb_ld(unsigned* p)              { return __hip_atomic_load(p, __ATOMIC_RELAXED, __HIP_MEMORY_SCOPE_AGENT); }
DI unsigned xb_add(unsigned* p, unsigned v) { return __hip_atomic_fetch_add(p, v, __ATOMIC_RELAXED, __HIP_MEMORY_SCOPE_AGENT); }
DI unsigned xb_xcc_id() { return (unsigned)__builtin_amdgcn_s_getreg((3 << 11) | 20) & 0xFu; }
#define XB_SPIN(cond, bar) do { unsigned _sp = 0; while (cond) { __builtin_amdgcn_s_sleep(1); \
    if ((++_sp & 255u) == 0u) { if (xb_ld(&(bar)[XB_TMO])) break; if (_sp > XB_SPIN_CAP) { xb_add(&(bar)[XB_TMO], 1u); break; } } } } while (0)
struct XcdBarrier { unsigned* bar; unsigned x; volatile LAS unsigned* st; };
DI XcdBarrier xcd_barrier_post(unsigned* bar, volatile LAS unsigned* st) {
    XcdBarrier b; b.bar = bar; b.x = xb_xcc_id(); b.st = st;
    if (threadIdx.x == 0) (void)xb_add(&bar[XB_XCNT(b.x)], 1u);
    return b;
}
DI void xcd_barrier_complete(unsigned* bar, unsigned x, unsigned& nloc, unsigned& nx) {
    const unsigned G = gridDim.x;
    unsigned sum, cnt, mine, sp = 0u;
    for (;;) {
        sum = 0u; cnt = 0u; mine = 0u;
#pragma unroll
        for (unsigned j = 0; j < 16; ++j) { const unsigned c = xb_ld(&bar[XB_XCNT(j)]); sum += c; cnt += (c > 0u) ? 1u : 0u; mine = (j == x) ? c : mine; }
        if (sum == G) break;
        __builtin_amdgcn_s_sleep(1);
        if ((++sp & 255u) == 0u) { if (xb_ld(&bar[XB_TMO])) break; if (sp > XB_SPIN_CAP) { xb_add(&bar[XB_TMO], 1u); break; } }
    }
    nloc = mine > 0u ? mine : 1u; nx = cnt > 0u ? cnt : 1u;
}
DI void grid_barrier(const XcdBarrier& b) {
    asm volatile("s_waitcnt vmcnt(0) lgkmcnt(0)" ::: "memory");
    __syncthreads();
    if (threadIdx.x == 0) {
        unsigned* bar = b.bar;
        unsigned nloc = b.st[0], nx = b.st[1];
        if (nloc == 0u) { xcd_barrier_complete(bar, b.x, nloc, nx); b.st[0] = nloc; b.st[1] = nx; }
        const unsigned old = xb_add(&bar[XB_XSUB(b.x)], 1u);
        const unsigned gen = old / nloc;
        if (old + 1u == (gen + 1u) * nloc) {
            __builtin_amdgcn_fence(__ATOMIC_RELEASE, "agent");
            asm volatile("s_waitcnt vmcnt(0)" ::: "memory");
            const unsigned og = xb_add(&bar[XB_TOP], 1u);
            const unsigned tg = og / nx;
            if (og + 1u == (tg + 1u) * nx) xb_add(&bar[XB_TOPGEN], 1u);
            else XB_SPIN(xb_ld(&bar[XB_TOPGEN]) == tg, bar);
            __builtin_amdgcn_fence(__ATOMIC_ACQUIRE, "agent");
            xb_add(&bar[XB_XGEN(b.x)], 1u);
            asm volatile("s_waitcnt vmcnt(0)" ::: "memory");
        } else {
            XB_SPIN(xb_ld(&bar[XB_XGEN(b.x)]) == gen, bar);
            __builtin_amdgcn_fence(__ATOMIC_ACQUIRE, "agent");
            asm volatile("s_waitcnt vmcnt(0)" ::: "memory");
        }
    }
    __syncthreads();
}

constexpr int LDS_BYTES = STAGE_BYTES + 8192;
__global__ void __launch_bounds__(512, 2) mega(Params p, int ph_lo, int ph_hi) {
    extern __shared__ __attribute__((aligned(16))) unsigned char lds_raw[];
    LAS unsigned char* lds = (LAS unsigned char*)lds_raw;
    volatile LAS unsigned* xst = (volatile LAS unsigned*)(lds + TAB_OFF + 8176);
    if (threadIdx.x == 0) { xst[0] = 0u; xst[1] = 0u; }
    __syncthreads();
    const XcdBarrier xb = xcd_barrier_post((unsigned*)(p.ws + OFF_BAR), xst);
    if (ph_lo < 0) cg::this_grid().sync();
#define PHASE(n, call) if (ph_lo <= (n) && (n) < ph_hi) { call; if ((n) + 1 < ph_hi) grid_barrier(xb); }
    PHASE(0, phase0(p, lds))
    PHASE(1, phase1(p, lds))
    PHASE(2, phase2(p, lds))
#ifdef PROBE_DUP2
    PHASE(2, phase2(p, lds))
#endif
    PHASE(3, phase3(p, lds))
#ifdef PROBE_DUP3
    PHASE(3, phase3(p, lds))
#endif
    PHASE(4, phase4(p, lds))
#ifdef PROBE_DUP4
    PHASE(4, phase4(p, lds))
#endif
    PHASE(5, phase5(p, lds))
#undef PHASE
}

extern "C" void kernel_launch(void* const* d_in, const int* in_sizes, int n_in, void* d_out, int out_size, void* d_ws, size_t ws_size,
                              hipStream_t stream) {
    static int grid_blocks = 0;
    if (!grid_blocks) {
        int dev = 0, cus = 0, per_cu = 0;
        (void)hipGetDevice(&dev);
        (void)hipDeviceGetAttribute(&cus, hipDeviceAttributeMultiprocessorCount, dev);
        (void)hipFuncSetAttribute((const void*)mega, hipFuncAttributeMaxDynamicSharedMemorySize, LDS_BYTES);
        (void)hipOccupancyMaxActiveBlocksPerMultiprocessor(&per_cu, (const void*)mega, 512, LDS_BYTES);
        if (per_cu < 1) per_cu = 1;
        if (per_cu > 1) per_cu = 1;
        grid_blocks = cus * per_cu;
    }
    Params p{};
    p.x = (const float*)d_in[0]; p.norm_mix = (const float*)d_in[1]; p.w_in = (const float*)d_in[2]; p.q_norm_a = (const float*)d_in[3];
    p.k_norm_a = (const float*)d_in[4]; p.rpb = (const float*)d_in[5]; p.out_norm_a = (const float*)d_in[6]; p.out_norm_b = (const float*)d_in[7];
    p.w_out = (const float*)d_in[8]; p.norm_ffn = (const float*)d_in[9]; p.w_gate = (const float*)d_in[10]; p.w_up = (const float*)d_in[11];
    p.w_down = (const float*)d_in[12]; p.norm_final = (const float*)d_in[13];
    p.out = (float*)d_out; p.ws = (unsigned char*)d_ws;
    int lo = 0, hi = 6;
    void* args[] = {&p, &lo, &hi};
    (void)hipMemsetAsync((unsigned char*)d_ws + OFF_BAR, 0, 16384 + 128 * 256, stream);
    hipError_t e = hipLaunchCooperativeKernel((const void*)mega, dim3(grid_blocks), dim3(512), args, LDS_BYTES, stream);
    if (e != hipSuccess) fprintf(stderr, "cooperative launch failed: %s (grid %d)\n", hipGetErrorString(e), grid_blocks);
}
```
